# Optimizing an MI355X kernel written in HIP

```python
import math
import jax, jax.numpy as jnp
from jax import lax
import numpy as np

D_MODEL = 1024
BATCH = 4
SEQ = 8192
DEPTH = 4

N_MIXERS = 2
N_ATTN_LAYERS = (DEPTH + 1) // 2
N_SSD_LAYERS = DEPTH // 2
N_HEADS = 16
N_KV_HEADS = 4
HEAD_DIM = 64
GQA_GROUP = N_HEADS // N_KV_HEADS
WINDOW = 128
ATTN_BLOCK = 128
ROT_DIM = HEAD_DIM // 4
ROPE_THETA = 500000.0
Q_DIM = N_HEADS * HEAD_DIM
KV_DIM = N_KV_HEADS * HEAD_DIM
QKV_DIM = Q_DIM + 2 * KV_DIM
SSD_EXPAND = 2
D_INNER = SSD_EXPAND * D_MODEL
SSD_HEAD_DIM = 64
SSD_HEADS = D_INNER // SSD_HEAD_DIM
SSD_GROUPS = 8
HEADS_PER_GROUP = SSD_HEADS // SSD_GROUPS
D_STATE = 128
SSD_CONV = 5
SSD_CHUNK = 128
CONV_DIM = D_INNER + 2 * SSD_GROUPS * D_STATE
SSD_IN_DIM = D_INNER + CONV_DIM + 2 * SSD_HEADS
D_FF = 2816
FFN_CONV = 3
EPS = 1e-6

kernel_name = "bidir_swa_sink_ssd_convffn_hybrid"


def rmsnorm(x, g):
    xf = x.astype(jnp.float32)
    y = xf * lax.rsqrt(jnp.mean(xf * xf, axis=-1, keepdims=True) + EPS)
    return (y * g.astype(jnp.float32)).astype(x.dtype)


def dwconv_centred(x, w, b):
    k_w = w.shape[0]
    pad = k_w // 2
    s = x.shape[1]
    xp = jnp.pad(x, ((0, 0), (pad, pad), (0, 0)))
    y = b + xp[:, 0:s] * w[0]
    for k in range(1, k_w):
        y = y + xp[:, k:k + s] * w[k]
    return y


def rope_partial(t, cos, sin):
    half = ROT_DIM // 2
    c = cos[None, :, None, :]
    s = sin[None, :, None, :]
    t1 = t[..., :half].astype(jnp.float32)
    t2 = t[..., half:ROT_DIM].astype(jnp.float32)
    rot = jnp.concatenate([t1 * c - t2 * s, t2 * c + t1 * s], axis=-1).astype(t.dtype)
    return jnp.concatenate([rot, t[..., ROT_DIM:]], axis=-1)


def window_attention(x, norm_g, w_qkv, q_g, k_g, sink, w_o, cos, sin):
    bsz, s_len, _ = x.shape
    nb = s_len // ATTN_BLOCK
    h = rmsnorm(x, norm_g)
    qkv = h @ w_qkv
    q = qkv[..., :Q_DIM].reshape(bsz, s_len, N_HEADS, HEAD_DIM)
    k = qkv[..., Q_DIM:Q_DIM + KV_DIM].reshape(bsz, s_len, N_KV_HEADS, HEAD_DIM)
    v = qkv[..., Q_DIM + KV_DIM:].reshape(bsz, s_len, N_KV_HEADS, HEAD_DIM)
    q = rope_partial(rmsnorm(q, q_g), cos, sin)
    k = rope_partial(rmsnorm(k, k_g), cos, sin)
    q = q.reshape(bsz, nb, ATTN_BLOCK, N_KV_HEADS, GQA_GROUP, HEAD_DIM)

    def band(t):
        tp = jnp.pad(t, ((0, 0), (ATTN_BLOCK, ATTN_BLOCK), (0, 0), (0, 0)))
        tp = tp.reshape(bsz, nb + 2, ATTN_BLOCK, N_KV_HEADS, HEAD_DIM)
        return jnp.concatenate([tp[:, :-2], tp[:, 1:-1], tp[:, 2:]], axis=2)

    kb = band(k)
    vb = band(v)
    scale = HEAD_DIM ** -0.5
    sc = jnp.einsum('bnqkgd,bntkd->bnkgqt', q, kb).astype(jnp.float32) * scale
    blk = jnp.arange(nb)[:, None] * ATTN_BLOCK
    qpos = blk + jnp.arange(ATTN_BLOCK)[None, :]
    kpos = blk - ATTN_BLOCK + jnp.arange(3 * ATTN_BLOCK)[None, :]
    valid = (jnp.abs(qpos[:, :, None] - kpos[:, None, :]) <= WINDOW) \
        & (kpos >= 0)[:, None, :] & (kpos < s_len)[:, None, :]
    sc = jnp.where(valid[None, :, None, None], sc, -1e30)
    sink_l = sink.astype(jnp.float32).reshape(N_KV_HEADS, GQA_GROUP)[None, None, :, :, None, None]
    m = jnp.maximum(jnp.max(sc, axis=-1, keepdims=True), sink_l)
    p = jnp.exp(sc - m)
    denom = jnp.sum(p, axis=-1, keepdims=True) + jnp.exp(sink_l - m)
    p = (p / denom).astype(v.dtype)
    o = jnp.einsum('bnkgqt,bntkd->bnqkgd', p, vb).reshape(bsz, s_len, Q_DIM)
    return o @ w_o


def ssd_chunked(x, dt, a_diag, bm, cm):
    b, s_len, _, p = x.shape
    c = s_len // SSD_CHUNK
    xf = x.astype(jnp.float32)
    xdt = (xf * dt[..., None]).reshape(b, c, SSD_CHUNK, SSD_GROUPS, HEADS_PER_GROUP, p)
    a = (dt * a_diag).reshape(b, c, SSD_CHUNK, SSD_GROUPS, HEADS_PER_GROUP)
    bc = bm.astype(jnp.float32).reshape(b, c, SSD_CHUNK, SSD_GROUPS, D_STATE)
    cc = cm.astype(jnp.float32).reshape(b, c, SSD_CHUNK, SSD_GROUPS, D_STATE)
    a_cum = jnp.cumsum(a, axis=2)
    diff = a_cum[:, :, :, None] - a_cum[:, :, None, :]
    lower = jnp.tril(jnp.ones((SSD_CHUNK, SSD_CHUNK), dtype=bool))[:, :, None, None]
    decay_mat = jnp.exp(jnp.where(lower, diff, -jnp.inf))
    cb = jnp.einsum('bclgn,bcsgn->bclsg', cc, bc)
    y_diag = jnp.einsum('bclsgr,bcsgrp->bclgrp', cb[..., None] * decay_mat, xdt)
    decay_to_end = jnp.exp(a_cum[:, :, -1:] - a_cum)
    states = jnp.einsum('bclgn,bclgrp->bcgrpn', bc, xdt * decay_to_end[..., None])
    chunk_decay = jnp.exp(a_cum[:, :, -1])

    def step(h, inp):
        st, dc = inp
        return dc[..., None, None] * h + st, h

    h0 = jnp.zeros((b, SSD_GROUPS, HEADS_PER_GROUP, p, D_STATE), jnp.float32)
    _, prev = lax.scan(step, h0, (jnp.moveaxis(states, 1, 0), jnp.moveaxis(chunk_decay, 1, 0)))
    prev = jnp.moveaxis(prev, 0, 1)
    y_off = jnp.einsum('bclgn,bcgrpn->bclgrp', cc, prev) * jnp.exp(a_cum)[..., None]
    return (y_diag + y_off).reshape(b, s_len, SSD_HEADS, p)


def ssd_mixer(x, norm_g, w_in, conv_w, conv_b, dt_bias, a_log, d_skip, gate_g, w_out):
    bsz, s_len, _ = x.shape
    h = rmsnorm(x, norm_g)
    zxbcdt = h @ w_in
    z = zxbcdt[..., :D_INNER]
    xbc = zxbcdt[..., D_INNER:D_INNER + CONV_DIM]
    dt_raw = zxbcdt[..., D_INNER + CONV_DIM:]
    xbc = jax.nn.silu(dwconv_centred(xbc, conv_w, conv_b))
    gn = SSD_GROUPS * D_STATE
    xs = xbc[..., :D_INNER].reshape(bsz, s_len, SSD_HEADS, SSD_HEAD_DIM)
    bm = xbc[..., D_INNER:D_INNER + gn].reshape(bsz, s_len, SSD_GROUPS, D_STATE)
    cm = xbc[..., D_INNER + gn:].reshape(bsz, s_len, SSD_GROUPS, D_STATE)
    dt = jax.nn.softplus(dt_raw.astype(jnp.float32).reshape(bsz, s_len, 2, SSD_HEADS)
                         + dt_bias.astype(jnp.float32))
    a_diag = -jnp.exp(a_log.astype(jnp.float32))
    flip = lambda t: jnp.flip(t, axis=1)
    y_fwd = ssd_chunked(xs, dt[:, :, 0], a_diag[0], bm, cm)
    y_bwd = flip(ssd_chunked(flip(xs), flip(dt[:, :, 1]), a_diag[1], flip(bm), flip(cm)))
    y = y_fwd + y_bwd + xs.astype(jnp.float32) * d_skip.astype(jnp.float32)[:, None]
    y = y.reshape(bsz, s_len, D_INNER) * jax.nn.silu(z.astype(jnp.float32))
    yg = y.reshape(bsz, s_len, SSD_GROUPS, D_INNER // SSD_GROUPS)
    yg = yg * lax.rsqrt(jnp.mean(yg * yg, axis=-1, keepdims=True) + EPS)
    y = yg.reshape(bsz, s_len, D_INNER) * gate_g.astype(jnp.float32)
    return y.astype(x.dtype) @ w_out


def conv_ffn(x, norm_g, w_up, conv_w, conv_b, w_down):
    h = rmsnorm(x, norm_g) @ w_up
    h = dwconv_centred(h, conv_w, conv_b)
    gate = h[..., :D_FF]
    val = h[..., D_FF:]
    return (jax.nn.silu(gate) * val) @ w_down


def setup_inputs(seed: int = 0) -> dict:
    key = jax.random.key(seed)
    ks = jax.random.split(key, 24)
    f32 = jnp.float32

    def nrm(k, shape, scale):
        return jax.random.normal(k, shape, f32) * scale

    na, ns = N_ATTN_LAYERS, N_SSD_LAYERS
    dt0 = jnp.exp(jax.random.uniform(ks[11], (ns, 2, SSD_HEADS), f32,
                                     minval=math.log(1e-3), maxval=math.log(1e-1)))
    return {
        "x": nrm(ks[0], (BATCH, SEQ, D_MODEL), 1.0),
        "attn_norm": 1.0 + nrm(ks[1], (na, D_MODEL), 0.02),
        "attn_w_qkv": nrm(ks[2], (na, D_MODEL, QKV_DIM), D_MODEL ** -0.5),
        "attn_q_norm": 1.0 + nrm(ks[3], (na, HEAD_DIM), 0.02),
        "attn_k_norm": 1.0 + nrm(ks[4], (na, HEAD_DIM), 0.02),
        "attn_sink": nrm(ks[5], (na, N_HEADS), 0.5),
        "attn_w_o": nrm(ks[6], (na, Q_DIM, D_MODEL), Q_DIM ** -0.5),
        "ssd_norm": 1.0 + nrm(ks[7], (ns, D_MODEL), 0.02),
        "ssd_w_in": nrm(ks[8], (ns, D_MODEL, SSD_IN_DIM), D_MODEL ** -0.5),
        "ssd_conv_w": nrm(ks[9], (ns, SSD_CONV, CONV_DIM), SSD_CONV ** -0.5),
        "ssd_conv_b": nrm(ks[10], (ns, CONV_DIM), 0.02),
        "ssd_dt_bias": dt0 + jnp.log(-jnp.expm1(-dt0)),
        "ssd_a_log": jnp.log(jax.random.uniform(ks[12], (ns, 2, SSD_HEADS), f32, minval=1.0, maxval=16.0)),
        "ssd_d": 1.0 + nrm(ks[13], (ns, SSD_HEADS), 0.1),
        "ssd_gate_norm": 1.0 + nrm(ks[14], (ns, D_INNER), 0.02),
        "ssd_w_out": nrm(ks[15], (ns, D_INNER, D_MODEL), D_INNER ** -0.5),
        "ffn_norm": 1.0 + nrm(ks[16], (DEPTH, D_MODEL), 0.02),
        "ffn_w_up": nrm(ks[17], (DEPTH, D_MODEL, 2 * D_FF), D_MODEL ** -0.5),
        "ffn_conv_w": nrm(ks[18], (DEPTH, FFN_CONV, 2 * D_FF), FFN_CONV ** -0.5),
        "ffn_conv_b": nrm(ks[19], (DEPTH, 2 * D_FF), 0.02),
        "ffn_w_down": nrm(ks[20], (DEPTH, D_FF, D_MODEL), D_FF ** -0.5),
    }


def reference(x, attn_norm, attn_w_qkv, attn_q_norm, attn_k_norm, attn_sink, attn_w_o,
              ssd_norm, ssd_w_in, ssd_conv_w, ssd_conv_b, ssd_dt_bias, ssd_a_log, ssd_d,
              ssd_gate_norm, ssd_w_out,
              ffn_norm, ffn_w_up, ffn_conv_w, ffn_conv_b, ffn_w_down):
    s_len = x.shape[1]
    pos = jnp.arange(s_len, dtype=jnp.float32)
    inv_freq = ROPE_THETA ** (-(jnp.arange(0, ROT_DIM, 2, dtype=jnp.float32) / ROT_DIM))
    ang = pos[:, None] * inv_freq[None, :]
    cos, sin = jnp.cos(ang), jnp.sin(ang)
    for i in range(DEPTH):
        j = i // N_MIXERS
        if i % N_MIXERS == 0:
            x = x + window_attention(x, attn_norm[j], attn_w_qkv[j], attn_q_norm[j],
                                     attn_k_norm[j], attn_sink[j], attn_w_o[j], cos, sin)
        else:
            x = x + ssd_mixer(x, ssd_norm[j], ssd_w_in[j], ssd_conv_w[j], ssd_conv_b[j],
                              ssd_dt_bias[j], ssd_a_log[j], ssd_d[j], ssd_gate_norm[j], ssd_w_out[j])
        x = x + conv_ffn(x, ffn_norm[i], ffn_w_up[i], ffn_conv_w[i], ffn_conv_b[i], ffn_w_down[i])
    return x
```

```cpp
#include <hip/hip_runtime.h>
#include <hip/hip_cooperative_groups.h>
#include <cstdio>
#include <cstdint>
namespace cg = cooperative_groups;
namespace pg8 {
#define PG8_LAS __attribute__((address_space(3)))
typedef unsigned short bf16_t;
typedef short bf16x8 __attribute__((ext_vector_type(8)));
typedef float f32x4 __attribute__((ext_vector_type(4)));
typedef unsigned u32x4 __attribute__((ext_vector_type(4)));
constexpr int BM = 256, BK = 64, HALF = 128, HTB = HALF * BK * 2  , STAGE_BYTES = 8 * HTB, NXCD = 8, WGM = 8;

__host__ __device__ __forceinline__ int lds_byte(int r, int c) { const int st = (r >> 4) * 2 + (c >> 5), rr = r & 15, cc = c & 31, ob = rr * 64 + cc * 2; return st * 1024 + (ob ^ (((ob >> 9) & 1) << 5)); }
__host__ __device__ __forceinline__ void stage_rc(int b, int& R, int& C) { const int st = b / 1024, sb = b % 1024, swz = sb ^ (((sb >> 9) & 1) << 5); R = (st >> 1) * 16 + swz / 64; C = (st & 1) * 32 + (swz % 64) / 2; }
__host__ __device__ __forceinline__ int perm32(int rho) { const int n = rho >> 4, i = rho & 15; return 8 * (i >> 2) + 4 * n + (i & 3); }

struct Unit { int pm, pn; };
struct Gemm { const bf16_t* A; const bf16_t* Bt; int M, N, K, amode; };

struct StaticOrder {
    int nM, nN, nwg, G, c;
    __host__ __device__ void init(int M, int N, int G_, int c_) { nM = M / BM; nN = N / BM; nwg = nM * nN; G = G_; c = c_; }
    __host__ __device__ bool next(int i, Unit& u) const {
        const long L = (long)i * G + c; if (L >= nwg) return false;
        int wgid = (int)L; { const int q = nwg / NXCD, r = nwg % NXCD, xcd = wgid % NXCD, off = wgid / NXCD; wgid = (xcd < r ? xcd * (q + 1) : r * (q + 1) + (xcd - r) * q) + off; }
        const int nig = WGM * nN, gid = wgid / nig, fm = gid * WGM, gsz = (nM - fm) < WGM ? (nM - fm) : WGM;
        u.pm = fm + ((wgid % nig) % gsz); u.pn = (wgid % nig) / gsz; return true;
    }
    __device__ __forceinline__ void a_ready(const Unit&) const {}
    __device__ __forceinline__ void done(const Unit&) const {}
};


__device__ __forceinline__ unsigned cvt_pk_bf16(float lo, float hi) { unsigned r; asm volatile("v_cvt_pk_bf16_f32 %0, %1, %2" : "=v"(r) : "v"(lo), "v"(hi)); return r; }
template <class Epi, class Sched, bool ALIGN_EPI = false, bool SP2 = false>
__device__ __forceinline__ void gemm_phase(PG8_LAS unsigned char* lds, const Gemm g, const Sched& S, const Epi& E) {
    int tid_ = threadIdx.x; asm volatile("" : "+v"(tid_)); const int tid = tid_, wid = __builtin_amdgcn_readfirstlane(tid >> 6), lane = tid & 63, wr = wid >> 2, wc = wid & 3, fr = lane & 15, fq = lane >> 4;
    const int K = g.K, nt = K / BK;
    unsigned voffA[2], voffB[2];
#pragma unroll
    for (int i = 0; i < 2; ++i) { int R, C; stage_rc(tid * 16 + i * 8192, R, C); const int Rb = Epi::PERM ? ((R & ~31) + perm32(R & 31)) : R;
        const int Ra = (g.amode != 0) ? (((R >> 6) ? (g.amode == 2 ? 124 : 126) : 0) + 8 * (R & 15) + ((R >> 4) & 3)) : R;
        voffA[i] = (unsigned)(Ra * K + C) * 2u; voffB[i] = (unsigned)(Rb * K + C) * 2u; }
    const size_t kstep = (size_t)(BK * 2);
    const size_t hstep = (size_t)HALF * K * 2;
    const size_t tstep = 2 * hstep;
    const size_t hstepA = (g.amode != 0) ? (size_t)4 * K * 2 : hstep;
#define PG8_ABASE(pm_) ((g.amode == 1) ? ((const char*)g.A + ((ptrdiff_t)((pm_) / 33) * 8192 + (ptrdiff_t)((pm_) % 33) * 252 - 1) * (ptrdiff_t)K * 2) : (g.amode == 2) ? ((const char*)g.A + ((ptrdiff_t)((pm_) / 34) * 8192 + (ptrdiff_t)((pm_) % 34) * 248 - 2) * (ptrdiff_t)K * 2) : ((const char*)g.A + (size_t)(pm_) * tstep))
    const unsigned ldsw = (unsigned)wid * 1024u;
    const int aoff = lds_byte(wr * 64 + fr, fq * 8), boff = lds_byte(wc * 32 + fr, fq * 8);
#define PG8_SA(b, h) (((b) * 2 + (h)) * HTB)
#define PG8_SB(b, h) ((4 + (b) * 2 + (h)) * HTB)
#define PG8_STAGE(bufoff, gbase, voff) do { _Pragma("unroll") for (int _i = 0; _i < 2; ++_i) \
        __builtin_amdgcn_global_load_lds((const unsigned*)((const char*)(gbase) + (voff)[_i]), (PG8_LAS unsigned*)(lds + (bufoff) + ldsw + _i * 8192), 16, 0, 0); } while (0)
#define PG8_LDA(dst, b, h) do { _Pragma("unroll") for (int m = 0; m < 4; ++m) _Pragma("unroll") for (int k = 0; k < 2; ++k) dst[m][k] = *(const PG8_LAS bf16x8*)(lds + PG8_SA(b, h) + aoff + m * 2048 + k * 1024); } while (0)
#define PG8_LDB(dst, b, h) do { _Pragma("unroll") for (int n = 0; n < 2; ++n) _Pragma("unroll") for (int k = 0; k < 2; ++k) dst[n][k] = *(const PG8_LAS bf16x8*)(lds + PG8_SB(b, h) + boff + n * 2048 + k * 1024); } while (0)
#define PG8_MMA(ai, bj, At, Bt) do { __builtin_amdgcn_s_setprio(1); _Pragma("unroll") for (int m = 0; m < 4; ++m) _Pragma("unroll") for (int n = 0; n < 2; ++n) _Pragma("unroll") for (int k = 0; k < 2; ++k) \
        acc[ai][bj][m][n] = __builtin_amdgcn_mfma_f32_16x16x32_bf16(Bt[n][k], At[m][k], acc[ai][bj][m][n], 0, 0, 0); __builtin_amdgcn_s_setprio(0); } while (0)
#define PG8_WAIT_V(n) asm volatile("s_waitcnt vmcnt(" #n ")" ::: "memory")
#define PG8_WAIT_L(n) asm volatile("s_waitcnt lgkmcnt(" #n ")" ::: "memory")
#define PG8_BAR __builtin_amdgcn_s_barrier()
#define PG8_SCHED __builtin_amdgcn_sched_barrier(0)
    Unit cur, nxt; int ui = 0;
    if (!S.next(0, cur)) return;
    f32x4 acc[2][2][4][2];
#pragma unroll
    for (int a = 0; a < 2; ++a)
#pragma unroll
        for (int b = 0; b < 2; ++b)
#pragma unroll
            for (int m = 0; m < 4; ++m)
#pragma unroll
                for (int n = 0; n < 2; ++n) acc[a][b][m][n] = (f32x4){0.f, 0.f, 0.f, 0.f};
    bf16x8 At[4][2], B0[2][2], B1[2][2];
    const char* cA = PG8_ABASE(cur.pm); const char* cB = (const char*)g.Bt + (size_t)cur.pn * tstep;
    S.a_ready(cur);
    if constexpr (SP2) {
        PG8_STAGE(PG8_SB(0, 0), cB, voffB); PG8_STAGE(PG8_SB(0, 1), cB + hstep, voffB); PG8_STAGE(PG8_SA(0, 0), cA, voffA); PG8_STAGE(PG8_SA(0, 1), cA + hstepA, voffA);
        if (wr == 1) PG8_BAR;
        PG8_WAIT_V(2); PG8_BAR;
        PG8_STAGE(PG8_SB(1, 0), cB + kstep, voffB); PG8_STAGE(PG8_SA(1, 0), cA + kstep, voffA); PG8_STAGE(PG8_SB(1, 1), cB + hstep + kstep, voffB);
        PG8_WAIT_V(6); PG8_BAR;
    } else {
        PG8_STAGE(PG8_SB(0, 0), cB, voffB); PG8_STAGE(PG8_SA(0, 0), cA, voffA); PG8_STAGE(PG8_SB(0, 1), cB + hstep, voffB); PG8_STAGE(PG8_SA(0, 1), cA + hstepA, voffA);
        if (wr == 1) PG8_BAR;
        PG8_WAIT_V(4); PG8_BAR;
        PG8_STAGE(PG8_SB(1, 0), cB + kstep, voffB); PG8_STAGE(PG8_SA(1, 0), cA + kstep, voffA); PG8_STAGE(PG8_SB(1, 1), cB + hstep + kstep, voffB);
        PG8_WAIT_V(6); PG8_BAR;
    }
    for (;;) {
        const bool has_next = S.next(ui + 1, nxt);
        const char* nA = has_next ? PG8_ABASE(nxt.pm) : cA; const char* nB = has_next ? (const char*)g.Bt + (size_t)nxt.pn * tstep : cB;
        for (int t = 0; t < nt; t += 2) {
            const bool last = (t == nt - 2);
            const char* a1 = cA + (size_t)(t + 1) * kstep;
            const char* a2 = last ? nA : cA + (size_t)(t + 2) * kstep; const char* b2 = last ? nB : cB + (size_t)(t + 2) * kstep;
            const char* a3 = a2 + kstep; const char* b3 = b2 + kstep;
            if (last && has_next) S.a_ready(nxt);
            if constexpr (SP2) {
            PG8_LDB(B0, 0, 0); PG8_LDB(B1, 0, 1); PG8_SCHED; PG8_LDA(At, 0, 0); PG8_STAGE(PG8_SA(1, 1), a1 + hstepA, voffA);
            PG8_WAIT_V(8); PG8_WAIT_L(0); PG8_BAR; PG8_MMA(0, 0, At, B0); PG8_MMA(0, 1, At, B1); PG8_BAR; PG8_SCHED;
            PG8_LDA(At, 0, 1); PG8_STAGE(PG8_SB(0, 0), b2, voffB); PG8_STAGE(PG8_SB(0, 1), b2 + hstep, voffB); PG8_STAGE(PG8_SA(0, 0), a2, voffA);
            PG8_WAIT_V(8); PG8_WAIT_L(0); PG8_BAR; PG8_MMA(1, 0, At, B0); PG8_MMA(1, 1, At, B1); PG8_BAR; PG8_SCHED;
            PG8_LDB(B0, 1, 0); PG8_LDB(B1, 1, 1); PG8_SCHED; PG8_LDA(At, 1, 0); PG8_STAGE(PG8_SA(0, 1), a2 + hstepA, voffA);
            PG8_WAIT_V(8); PG8_WAIT_L(0); PG8_BAR; PG8_MMA(0, 0, At, B0); PG8_MMA(0, 1, At, B1); PG8_BAR; PG8_SCHED;
            PG8_LDA(At, 1, 1); PG8_STAGE(PG8_SB(1, 0), b3, voffB); PG8_STAGE(PG8_SB(1, 1), b3 + hstep, voffB); PG8_STAGE(PG8_SA(1, 0), a3, voffA);
            PG8_WAIT_V(8); PG8_WAIT_L(0); PG8_BAR; PG8_MMA(1, 0, At, B0); PG8_MMA(1, 1, At, B1); PG8_BAR; PG8_SCHED;
            } else {
            PG8_LDB(B0, 0, 0); PG8_SCHED; PG8_LDA(At, 0, 0); PG8_STAGE(PG8_SA(1, 1), a1 + hstepA, voffA);
            PG8_WAIT_L(8); PG8_BAR; PG8_WAIT_L(0); PG8_MMA(0, 0, At, B0); PG8_BAR; PG8_SCHED;
            PG8_LDB(B1, 0, 1); PG8_STAGE(PG8_SB(0, 0), b2, voffB);
            PG8_BAR; PG8_WAIT_L(0); PG8_MMA(0, 1, At, B1); PG8_BAR;
            PG8_LDA(At, 0, 1); PG8_STAGE(PG8_SA(0, 0), a2, voffA);
            PG8_BAR; PG8_WAIT_L(0); PG8_MMA(1, 0, At, B0); PG8_BAR; PG8_SCHED;
            PG8_STAGE(PG8_SB(0, 1), b2 + hstep, voffB);
            PG8_WAIT_V(6); PG8_BAR; PG8_MMA(1, 1, At, B1); PG8_BAR;
            PG8_LDB(B0, 1, 0); PG8_SCHED; PG8_LDA(At, 1, 0); PG8_STAGE(PG8_SA(0, 1), a2 + hstepA, voffA);
            PG8_WAIT_L(8); PG8_BAR; PG8_WAIT_L(0); PG8_MMA(0, 0, At, B0); PG8_BAR; PG8_SCHED;
            PG8_LDB(B1, 1, 1); PG8_STAGE(PG8_SB(1, 0), b3, voffB);
            PG8_BAR; PG8_WAIT_L(0); PG8_MMA(0, 1, At, B1); PG8_BAR;
            PG8_LDA(At, 1, 1); PG8_STAGE(PG8_SA(1, 0), a3, voffA);
            PG8_BAR; PG8_WAIT_L(0); PG8_MMA(1, 0, At, B0); PG8_BAR; PG8_SCHED;
            PG8_STAGE(PG8_SB(1, 1), b3 + hstep, voffB);
            PG8_WAIT_V(6); PG8_BAR; PG8_MMA(1, 1, At, B1); PG8_BAR;
            }
        }
        if constexpr (ALIGN_EPI) { if (wr == 0) PG8_BAR; }
        if constexpr (!Epi::AFTER_DRAIN) { E(acc, cur, wr, wc, fr, fq); S.done(cur); }
        if (!has_next) break;
#pragma unroll
        for (int a = 0; a < 2; ++a)
#pragma unroll
            for (int b = 0; b < 2; ++b)
#pragma unroll
                for (int m = 0; m < 4; ++m)
#pragma unroll
                    for (int n = 0; n < 2; ++n) acc[a][b][m][n] = (f32x4){0.f, 0.f, 0.f, 0.f};
        cur = nxt; cA = nA; cB = nB; ++ui;
        if constexpr (ALIGN_EPI) { if (wr == 1) PG8_BAR; }
    }
    PG8_WAIT_V(0);
    if constexpr (!ALIGN_EPI) { if (wr == 0) PG8_BAR; }
    PG8_BAR;
    if constexpr (Epi::AFTER_DRAIN) { E.fused(acc, cur, wr, wc, fr, fq, lds, wid, lane); S.done(cur); }
#undef PG8_ABASE
#undef PG8_SA
#undef PG8_SB
#undef PG8_STAGE
#undef PG8_LDA
#undef PG8_LDB
#undef PG8_MMA
#undef PG8_WAIT_V
#undef PG8_WAIT_L
#undef PG8_BAR
#undef PG8_SCHED
}
}

constexpr int SEQ = 8192, NBATCH = 4, DM = 1024, MTOK = NBATCH * SEQ, MH = MTOK / 2;
constexpr int QKVD = 1536, DFF = 2816, DFF2 = 5632, DIN = 2048, CONVD = 4096, SSDIN = 6208, SSDINP = 6400;
constexpr float EPSF = 1e-6f;
typedef unsigned short bf16;
typedef pg8::f32x4 f32x4;
typedef pg8::u32x4 u32x4;
typedef unsigned u32x2 __attribute__((ext_vector_type(2)));

constexpr size_t MiB = 1u << 20;
constexpr size_t WS_SS = 500 * MiB;
constexpr size_t WS_BAR = 0;
constexpr size_t WS_SWP = 64 * 1024;
constexpr size_t WS_CWP = 1 * MiB;
constexpr size_t WS_ROPE = 1536 * 1024;
constexpr size_t WS_W = 2 * MiB;
constexpr size_t W_ATT_STRIDE = 5 * MiB, W_ATT_WO = 3 * MiB;
constexpr size_t W_SSD0 = 10 * MiB, W_SSD_STRIDE = 16 * MiB + 512 * 1024, W_SSD_WOUT = 12 * MiB + 512 * 1024;
constexpr size_t W_FFN0 = 43 * MiB, W_FFN_STRIDE = 16 * MiB + 512 * 1024, W_FFN_DOWN = 11 * MiB;
constexpr size_t WS_XB = 112 * MiB;
constexpr size_t WS_R = 176 * MiB;
constexpr size_t R_QKV = WS_R, R_OB = WS_R + 96 * MiB;
constexpr size_t R_ACT = WS_R;
constexpr size_t R_Z = WS_R, R_RAW = WS_R + 64 * MiB, R_CONV = WS_R + 192 * MiB, R_DT = WS_R + 320 * MiB;
constexpr size_t R_YF = R_RAW, R_YB = R_RAW + 64 * MiB;
constexpr size_t WS_END = 502 * MiB;
static_assert(WS_END <= 512 * MiB, "ws map");

enum { K_GEMM = 0, K_ATTN = 1, K_FCONV = 2, K_SCONV = 3, K_MARCH = 4, K_COMB = 5 };
struct Step { int kind, layer, sub, hb; };
constexpr int MAXSTEPS = 96;
constexpr int PROBE = 0;
constexpr int MPROBE = 0;
struct Args { const float* in[21]; float* out; unsigned char* ws; int nsteps; int pad; Step steps[MAXSTEPS]; };

__device__ __forceinline__ int wave_id() { return __builtin_amdgcn_readfirstlane((int)(threadIdx.x >> 6)); }
__device__ __forceinline__ int otid() { int t = threadIdx.x; asm volatile("" : "+v"(t)); return t; }
__device__ __forceinline__ float bflo(unsigned u) { return __uint_as_float(u << 16); }
__device__ __forceinline__ float bfhi(unsigned u) { return __uint_as_float(u & 0xffff0000u); }
typedef float f32x2_t __attribute__((ext_vector_type(2))); typedef __bf16 bf16x2_t __attribute__((ext_vector_type(2)));
__device__ __forceinline__ unsigned pk2(float lo, float hi) { f32x2_t v = {lo, hi}; bf16x2_t b = __builtin_convertvector(v, bf16x2_t); return __builtin_bit_cast(unsigned, b); }
__device__ __forceinline__ float bf1(bf16 v) { return __uint_as_float(((unsigned)v) << 16); }
__device__ __forceinline__ float up1_16(float v) { return __builtin_bit_cast(float, __builtin_amdgcn_update_dpp(__builtin_bit_cast(int, v), __builtin_bit_cast(int, v), 0x111, 0xf, 0xf, false)); }
__device__ __forceinline__ float dn1_16(float v) { return __builtin_bit_cast(float, __builtin_amdgcn_update_dpp(__builtin_bit_cast(int, v), __builtin_bit_cast(int, v), 0x101, 0xf, 0xf, false)); }
__device__ __forceinline__ float siluf(float x) { return x * __builtin_amdgcn_rcpf(1.f + __builtin_amdgcn_exp2f(-1.4426950408889634f * x)); }
__device__ __forceinline__ float wave_sum(float v) {
#pragma unroll
    for (int o = 1; o < 64; o <<= 1) v += __shfl_xor(v, o);
    return v;
}

struct EP { int mode, ld0, c0, ld1, c1, ld2, c2, pad; const float* ss_in; bf16* o0; bf16* o1; float* o2; const float* base; float* out; bf16* xb; float* ss_out; const float* cw; const float* cb; };
#define GAS1 __attribute__((address_space(1)))
struct EpiG {
    static constexpr bool PERM = true, AFTER_DRAIN = false;
    const PG8_LAS EP* ep;
    __device__ __forceinline__ void operator()(const f32x4 (&acc)[2][2][4][2], const pg8::Unit& u, int wr, int wc, int fr_, int fq_) const {
        int fr = fr_, fq = fq_; asm volatile("" : "+v"(fr), "+v"(fq));
        const int row0 = u.pm * 256 + wr * 64 + fr;
        const int colb = u.pn * 256 + wc * 32 + 8 * fq;
        const PG8_LAS EP* ep = this->ep; { unsigned epa = (unsigned)(size_t)ep; asm volatile("" : "+v"(epa)); ep = (const PG8_LAS EP*)(size_t)epa; }
        const int mode = ep->mode;
        if (mode == 0) {
            const GAS1 float* ss_in = (const GAS1 float*)ep->ss_in; GAS1 bf16* o0 = (GAS1 bf16*)ep->o0; GAS1 bf16* o1 = (GAS1 bf16*)ep->o1; GAS1 float* o2 = (GAS1 float*)ep->o2;
            const int ld0 = ep->ld0, c0 = ep->c0, ld1 = ep->ld1, c1 = ep->c1, ld2 = ep->ld2, c2 = ep->c2;
            f32x4 ppa[2][4];
#pragma unroll
            for (int ai = 0; ai < 2; ++ai)
#pragma unroll
                for (int m = 0; m < 4; ++m) ppa[ai][m] = *(const GAS1 f32x4*)(ss_in + (size_t)(row0 + ai * 128 + m * 16) * 4);
#pragma unroll
            for (int ai = 0; ai < 2; ++ai) {
                const f32x4 (&pp)[4] = ppa[ai];
#pragma unroll
                for (int m = 0; m < 4; ++m) {
                    const int row = row0 + ai * 128 + m * 16;
                    const float rs = rsqrtf(((pp[m][0] + pp[m][1]) + (pp[m][2] + pp[m][3])) * (1.0f / 1024.0f) + EPSF);
#pragma unroll
                    for (int bj = 0; bj < 2; ++bj) {
                        const int col = colb + bj * 128;
                        const f32x4 v0 = acc[ai][bj][m][0] * rs, v1 = acc[ai][bj][m][1] * rs;
                        if (col < c1) {
                            u32x4 w; w.x = pk2(v0[0], v0[1]); w.y = pk2(v0[2], v0[3]); w.z = pk2(v1[0], v1[1]); w.w = pk2(v1[2], v1[3]);
                            if (col < c0) *(GAS1 u32x4*)(o0 + (size_t)row * ld0 + col) = w;
                            else *(GAS1 u32x4*)(o1 + (size_t)row * ld1 + (col - c0)) = w;
                        } else if (col < c2) {
                            GAS1 float* p = o2 + (size_t)row * ld2 + (col - c1);
                            *(GAS1 f32x4*)p = v0; *(GAS1 f32x4*)(p + 4) = v1;
                        }
                    }
                }
                asm volatile("" ::: "memory");
            }
        } else if (mode == 4) {
            GAS1 bf16* o0 = (GAS1 bf16*)ep->o0; const int ld0 = ep->ld0;
#pragma unroll
            for (int ai = 0; ai < 2; ++ai)
#pragma unroll
                for (int m = 0; m < 4; ++m) { const int row = row0 + ai * 128 + m * 16;
#pragma unroll
                    for (int bj = 0; bj < 2; ++bj) { const f32x4 v0 = acc[ai][bj][m][0], v1 = acc[ai][bj][m][1];
                        u32x4 w; w.x = pk2(v0[0], v0[1]); w.y = pk2(v0[2], v0[3]); w.z = pk2(v1[0], v1[1]); w.w = pk2(v1[2], v1[3]);
                        *(GAS1 u32x4*)(o0 + (size_t)row * ld0 + colb + bj * 128) = w; } }
        } else if (mode == 2) {
            const GAS1 float* ss_in = (const GAS1 float*)ep->ss_in;
            const f32x4 pv2 = *(const GAS1 f32x4*)((const GAS1 float*)ep->cw + (size_t)((u.pn * 128 + wc * 32) >> 2) * 32 + (16 * fq + fr) * 4);
            const int sb = u.pm / 33, ti = u.pm - sb * 33;
            const int tok0 = 252 * ti - 1 + 126 * wr + 8 * fr;
            const size_t rowb = (size_t)sb * SEQ;
            float rs[8];
#pragma unroll
            for (int kb = 0; kb < 1; ++kb) {
                f32x4 pp[8]; bool okr[8];
#pragma unroll
                for (int kk = 0; kk < 8; ++kk) { const int tok = tok0 + kk; okr[kk] = tok >= 0 && tok < SEQ; const int tokc = okr[kk] ? tok : 0;
                    pp[kk] = *(const GAS1 f32x4*)(ss_in + (rowb + tokc) * 4); }
#pragma unroll
                for (int kk = 0; kk < 8; ++kk) { const float r = rsqrtf(((pp[kk][0] + pp[kk][1]) + (pp[kk][2] + pp[kk][3])) * (1.0f / 1024.0f) + EPSF);
                    float rk = okr[kk] ? r : 0.f; asm volatile("" : "+v"(rk)); rs[kk] = rk; }
            }
            GAS1 bf16* act = (GAS1 bf16*)ep->o0;
            PG8_LAS unsigned char* wl = (PG8_LAS unsigned char*)(size_t)(131072 + 256 + (wr * 4 + wc) * 1536);
            *(PG8_LAS f32x4*)(wl + (16 * fq + fr) * 16) = pv2;
#pragma unroll
            for (int kh = 0; kh < 2; ++kh) {
                unsigned outp[4][4];
#pragma unroll
                for (int q = 0; q < 4; ++q) {
                    const int n = q >> 1, e0 = 2 * (q & 1);
                    asm volatile("" : "+v"(rs[0]), "+v"(rs[1]), "+v"(rs[2]), "+v"(rs[3]), "+v"(rs[4]), "+v"(rs[5]), "+v"(rs[6]), "+v"(rs[7]));
                    typedef float f2 __attribute__((ext_vector_type(2)));
                    const PG8_LAS float* wp = (const PG8_LAS float*)(wl + ((2 * fq + n) * 32 + e0) * 4);
                    const f2 wg0 = *(const PG8_LAS f2*)(wp), wg1 = *(const PG8_LAS f2*)(wp + 4), wg2 = *(const PG8_LAS f2*)(wp + 8), bg = *(const PG8_LAS f2*)(wp + 12);
                    const f2 wv0 = *(const PG8_LAS f2*)(wp + 16), wv1 = *(const PG8_LAS f2*)(wp + 20), wv2 = *(const PG8_LAS f2*)(wp + 24), bv = *(const PG8_LAS f2*)(wp + 28);
#define SX(bj_, k_) ((f2){acc[(k_) >> 2][bj_][(k_) & 3][n][e0], acc[(k_) >> 2][bj_][(k_) & 3][n][e0 + 1]} * rs[k_])
                    f2 gm, gc, gp, vm, vc, vp, gl, vl;
                    if (kh == 0) { const f2 g7 = SX(0, 7), v7 = SX(1, 7);
                        gm[0] = up1_16(g7[0]); gm[1] = up1_16(g7[1]); vm[0] = up1_16(v7[0]); vm[1] = up1_16(v7[1]);
                        gl = SX(0, 4); vl = SX(1, 4); gc = SX(0, 0); vc = SX(1, 0);
                    } else { const f2 g0 = SX(0, 0), v0 = SX(1, 0);
                        gl[0] = dn1_16(g0[0]); gl[1] = dn1_16(g0[1]); vl[0] = dn1_16(v0[0]); vl[1] = dn1_16(v0[1]);
                        gm = SX(0, 3); vm = SX(1, 3); gc = SX(0, 4); vc = SX(1, 4); }
#pragma unroll
                    for (int kk = 0; kk < 4; ++kk) {
                        const int k = 4 * kh + kk;
                        if (kk < 3) { gp = SX(0, (kk < 3 ? k + 1 : k)); vp = SX(1, (kk < 3 ? k + 1 : k)); } else { gp = gl; vp = vl; }
                        const f2 G = bg + wg0 * gm + wg1 * gc + wg2 * gp, V = bv + wv0 * vm + wv1 * vc + wv2 * vp;
                        outp[kk][q] = pk2(siluf(G[0]) * V[0], siluf(G[1]) * V[1]);
                        gm = gc; gc = gp; vm = vc; vc = vp;
                    }
#undef SX
                    asm volatile("" : "+v"(outp[0][q]), "+v"(outp[1][q]), "+v"(outp[2][q]), "+v"(outp[3][q]) :: "memory");
                }
#pragma unroll
                for (int kk = 0; kk < 4; ++kk) { int kx = 4 * kh + kk; asm volatile("" : "+v"(kx));
                    const int sidx = 8 * fr + kx, tok = tok0 + kx;
                    if (sidx >= 1 && sidx <= 126 && tok < SEQ) { u32x4 w; w.x = outp[kk][0]; w.y = outp[kk][1]; w.z = outp[kk][2]; w.w = outp[kk][3];
                        *(GAS1 u32x4*)(act + (rowb + tok) * DFF + u.pn * 128 + wc * 32 + 8 * fq) = w; } }
                asm volatile("" ::: "memory");
            }
        } else if (mode == 3) {
            const GAS1 float* ss_in = (const GAS1 float*)ep->ss_in;
            f32x4 pv3a = {0.f, 0.f, 0.f, 0.f}, pv3b = {0.f, 0.f, 0.f, 0.f};
            if (u.pn >= 8 && u.pn < 24 && 16 * fq + fr < 48) { const GAS1 float* src = (const GAS1 float*)ep->cw + (size_t)((u.pn * 256 + wc * 32 - DIN) >> 2) * 24 + (16 * fq + fr) * 4; pv3a = *(const GAS1 f32x4*)src; pv3b = *(const GAS1 f32x4*)(src + 768); }
            const int sb = u.pm / 34, ti = u.pm - sb * 34;
            const int tok0 = 248 * ti - 2 + 124 * wr + 8 * fr;
            const size_t rowb = (size_t)sb * SEQ;
            float rs[8];
#pragma unroll
            for (int kb = 0; kb < 1; ++kb) {
                f32x4 pp[8]; bool okr[8];
#pragma unroll
                for (int kk = 0; kk < 8; ++kk) { const int tok = tok0 + kk; okr[kk] = tok >= 0 && tok < SEQ; const int tokc = okr[kk] ? tok : 0;
                    pp[kk] = *(const GAS1 f32x4*)(ss_in + (rowb + tokc) * 4); }
#pragma unroll
                for (int kk = 0; kk < 8; ++kk) { const float r = rsqrtf(((pp[kk][0] + pp[kk][1]) + (pp[kk][2] + pp[kk][3])) * (1.0f / 1024.0f) + EPSF);
                    float rk = okr[kk] ? r : 0.f; asm volatile("" : "+v"(rk)); rs[kk] = rk; }
            }
            if (u.pn < 8) {
                GAS1 bf16* zo = (GAS1 bf16*)ep->o0;
#pragma unroll
                for (int k = 0; k < 8; ++k) { int kx = k; asm volatile("" : "+v"(kx)); const int sidx = 8 * fr + kx, tok = tok0 + kx;
                    if (sidx >= 2 && sidx <= 125 && tok < SEQ) {
#pragma unroll
                        for (int bj = 0; bj < 2; ++bj) { const f32x4 v0 = acc[k >> 2][bj][k & 3][0] * rs[k], v1 = acc[k >> 2][bj][k & 3][1] * rs[k];
                            u32x4 w; w.x = pk2(v0[0], v0[1]); w.y = pk2(v0[2], v0[3]); w.z = pk2(v1[0], v1[1]); w.w = pk2(v1[2], v1[3]);
                            *(GAS1 u32x4*)(zo + (rowb + tok) * DIN + colb + bj * 128) = w; } } }
            } else if (u.pn == 24) {
                if (wc < 2) { GAS1 float* dto = (GAS1 float*)ep->o2; const GAS1 float* dtb = (const GAS1 float*)ep->cb; const int c0 = wc * 32 + 8 * fq;
                    const f32x4 b0 = *(const GAS1 f32x4*)(dtb + c0), b1 = *(const GAS1 f32x4*)(dtb + c0 + 4);
#pragma unroll
                    for (int k = 0; k < 8; ++k) { int kx = k; asm volatile("" : "+v"(kx)); const int sidx = 8 * fr + kx, tok = tok0 + kx;
                        if (sidx >= 2 && sidx <= 125 && tok < SEQ) { f32x4 v0 = acc[k >> 2][0][k & 3][0] * rs[k] + b0, v1 = acc[k >> 2][0][k & 3][1] * rs[k] + b1;
#pragma unroll
                            for (int e = 0; e < 4; ++e) { v0[e] = fmaxf(v0[e], 0.f) + __logf(1.f + __expf(-fabsf(v0[e]))); v1[e] = fmaxf(v1[e], 0.f) + __logf(1.f + __expf(-fabsf(v1[e]))); }
                            GAS1 float* p = dto + (rowb + tok) * 64 + c0; *(GAS1 f32x4*)p = v0; *(GAS1 f32x4*)(p + 4) = v1; } } }
            } else {
                GAS1 bf16* co = (GAS1 bf16*)ep->o1;
                const int cc0 = colb - DIN;
                unsigned sbase[2]; const unsigned sstride = (cc0 < 2048) ? 32u : 256u;
#pragma unroll
                for (int bj = 0; bj < 2; ++bj) { const unsigned cc = (unsigned)(cc0 + bj * 128);
                    sbase[bj] = (cc < 2048u) ? ((cc >> 5) * (unsigned)(MH * 32) + (cc & 31u)) : (2048u * MH + (((cc - 2048u) & 1023u) >> 7) * (unsigned)(MH * 256) + ((cc >= 3072u) ? 128u : 0u) + (cc & 127u)); }
                PG8_LAS unsigned char* wl = (PG8_LAS unsigned char*)(size_t)(131072 + 256 + (wr * 4 + wc) * 1536);
                { const int ln = 16 * fq + fr; if (ln < 48) { *(PG8_LAS f32x4*)(wl + ln * 16) = pv3a; *(PG8_LAS f32x4*)(wl + 768 + ln * 16) = pv3b; } }
#pragma unroll
                for (int kh = 0; kh < 2; ++kh) {
#pragma unroll
                  for (int bj = 0; bj < 2; ++bj) {
                    unsigned outp[4][4];
#pragma unroll
                    for (int q = 0; q < 4; ++q) {
                        const int n = q >> 1, e0 = 2 * (q & 1);
                        asm volatile("" : "+v"(rs[0]), "+v"(rs[1]), "+v"(rs[2]), "+v"(rs[3]), "+v"(rs[4]), "+v"(rs[5]), "+v"(rs[6]), "+v"(rs[7]));
                        typedef float f2 __attribute__((ext_vector_type(2)));
                        const PG8_LAS float* wp = (const PG8_LAS float*)(wl + bj * 768 + ((2 * fq + n) * 24 + e0) * 4);
                        const f2 w0 = *(const PG8_LAS f2*)(wp), w1 = *(const PG8_LAS f2*)(wp + 4), w2 = *(const PG8_LAS f2*)(wp + 8), w3 = *(const PG8_LAS f2*)(wp + 12), w4 = *(const PG8_LAS f2*)(wp + 16), bb = *(const PG8_LAS f2*)(wp + 20);
#define SX(k_) ((f2){acc[(k_) >> 2][bj][(k_) & 3][n][e0], acc[(k_) >> 2][bj][(k_) & 3][n][e0 + 1]} * rs[k_])
                        f2 ha, hb, hc, hd, he, t1, t2;
                        if (kh == 0) { const f2 s6 = SX(6), s7 = SX(7);
                            ha[0] = up1_16(s6[0]); ha[1] = up1_16(s6[1]); hb[0] = up1_16(s7[0]); hb[1] = up1_16(s7[1]);
                            hc = SX(0); hd = SX(1); he = SX(2); t1 = SX(4); t2 = SX(5);
                        } else { const f2 s0 = SX(0), s1 = SX(1);
                            t1[0] = dn1_16(s0[0]); t1[1] = dn1_16(s0[1]); t2[0] = dn1_16(s1[0]); t2[1] = dn1_16(s1[1]);
                            ha = SX(2); hb = SX(3); hc = SX(4); hd = SX(5); he = SX(6); }
#pragma unroll
                        for (int kk = 0; kk < 4; ++kk) {
                            const f2 v = bb + w0 * ha + w1 * hb + w2 * hc + w3 * hd + w4 * he;
                            outp[kk][q] = pk2(siluf(v[0]), siluf(v[1]));
                            ha = hb; hb = hc; hc = hd; hd = he;
                            he = (kk == 0) ? SX((kh == 0) ? 3 : 7) : (kk == 1) ? t1 : t2;
                        }
#undef SX
                        asm volatile("" : "+v"(outp[0][q]), "+v"(outp[1][q]), "+v"(outp[2][q]), "+v"(outp[3][q]) :: "memory");
                    }
#pragma unroll
                    for (int kk = 0; kk < 4; ++kk) { int kx = 4 * kh + kk; asm volatile("" : "+v"(kx));
                        const int sidx = 8 * fr + kx, tok = tok0 + kx;
                        if (sidx >= 2 && sidx <= 125 && tok < SEQ) {
                            u32x4 wa; wa.x = outp[kk][0]; wa.y = outp[kk][1]; wa.z = outp[kk][2]; wa.w = outp[kk][3];
                            *(GAS1 u32x4*)(co + (sbase[bj] + (unsigned)(rowb + tok) * sstride)) = wa; } }
                    asm volatile("" ::: "memory");
                  }
                }
            }
        } else {
            GAS1 float* out = (GAS1 float*)ep->out; GAS1 bf16* xb = (GAS1 bf16*)ep->xb; GAS1 float* ss_out = (GAS1 float*)ep->ss_out;
#pragma unroll
            for (int ai = 0; ai < 2; ++ai) {
                u32x4 bb[4][2];
#pragma unroll
                for (int m = 0; m < 4; ++m)
#pragma unroll
                    for (int bj = 0; bj < 2; ++bj) bb[m][bj] = *(const GAS1 u32x4*)(xb + (size_t)(row0 + ai * 128 + m * 16) * 1024 + colb + bj * 128);
#pragma unroll
                for (int m = 0; m < 4; ++m) {
                    const int row = row0 + ai * 128 + m * 16;
                    float sq = 0.f;
#pragma unroll
                    for (int bj = 0; bj < 2; ++bj) {
                        const size_t off = (size_t)row * 1024 + colb + bj * 128; const u32x4 bw = bb[m][bj];
                        const f32x4 b0 = {bflo(bw.x), bfhi(bw.x), bflo(bw.y), bfhi(bw.y)}, b1 = {bflo(bw.z), bfhi(bw.z), bflo(bw.w), bfhi(bw.w)};
                        const f32x4 v0 = acc[ai][bj][m][0] + b0, v1 = acc[ai][bj][m][1] + b1;
                        if (out) { *(GAS1 f32x4*)(out + off) = v0; *(GAS1 f32x4*)(out + off + 4) = v1; }
                        u32x4 w; w.x = pk2(v0[0], v0[1]); w.y = pk2(v0[2], v0[3]); w.z = pk2(v1[0], v1[1]); w.w = pk2(v1[2], v1[3]);
                        *(GAS1 u32x4*)(xb + off) = w;
                        const f32x4 r0 = {bflo(w.x), bfhi(w.x), bflo(w.y), bfhi(w.y)}, r1 = {bflo(w.z), bfhi(w.z), bflo(w.w), bfhi(w.w)};
                        sq += (r0[0] * r0[0] + r0[1] * r0[1]) + (r0[2] * r0[2] + r0[3] * r0[3]) + (r1[0] * r1[0] + r1[1] * r1[1]) + (r1[2] * r1[2] + r1[3] * r1[3]);
                    }
                    sq += __shfl_xor(sq, 16); sq += __shfl_xor(sq, 32);
                    if (fq == 0) *(PG8_LAS float*)(size_t)(131328 + ((ai * 128 + wr * 64 + m * 16 + fr) * 4 + wc) * 4) = sq;
                }
                asm volatile("" ::: "memory");
            }
            asm volatile("s_waitcnt lgkmcnt(0)\n\ts_barrier" ::: "memory");
            if (fq < 2) { const int rl = (wr * 4 + wc) * 32 + 16 * fq + fr; const f32x4 q = *(const PG8_LAS f32x4*)(size_t)(131328 + rl * 16);
                ss_out[(size_t)(u.pm * 256 + rl) * 4 + u.pn] = (q[0] + q[1]) + (q[2] + q[3]); }
        }
    }
};

__device__ __forceinline__ void p0_transpose_item(const float* W, const float* g, int K, int N, bf16* WT, float* scr, int item, int lane, int permup) {
    const int nblk = N / 32, kb = item / nblk, nb = item % nblk, k0 = 64 * kb, n0 = 32 * nb;
    float wv[32];
#pragma unroll
    for (int i = 0; i < 32; ++i) wv[i] = __builtin_nontemporal_load(&W[(size_t)(k0 + 2 * i + (lane >> 5)) * N + n0 + (lane & 31)]);
#pragma unroll
    for (int i = 0; i < 32; ++i) { const int kk = 2 * i + (lane >> 5); float v = wv[i]; if (g) v *= g[k0 + kk]; scr[kk * 33 + (lane & 31)] = v; }
    asm volatile("s_waitcnt lgkmcnt(0)" ::: "memory");
    const int c = lane & 7;
#pragma unroll
    for (int j = 0; j < 4; ++j) { const int n = (lane >> 3) + 8 * j; const float* s = scr + (8 * c) * 33 + n;
        u32x4 o; o.x = pk2(s[0 * 33], s[1 * 33]); o.y = pk2(s[2 * 33], s[3 * 33]); o.z = pk2(s[4 * 33], s[5 * 33]); o.w = pk2(s[6 * 33], s[7 * 33]);
        int nr = n0 + n; if (permup) { const int hv = nr >= DFF ? 1 : 0, jj = nr - hv * DFF; nr = 256 * (jj >> 7) + 128 * hv + (jj & 127); }
        *(u32x4*)(WT + (size_t)nr * K + k0 + 8 * c) = o; }
    asm volatile("s_waitcnt lgkmcnt(0)" ::: "memory");
}
__device__ __forceinline__ void p0_matrix(const float* W, const float* g, int K, int N, bf16* WT, float* scr, int gw, int NGW, int lane, int permup = 0) {
    const int nitems = (K / 64) * (N / 32);
    for (int it = gw; it < nitems; it += NGW) p0_transpose_item(W, g, K, N, WT, scr, it, lane, permup);
}

__device__ __forceinline__ void phase0(const Args& a, unsigned char* lds) {
    const int tid = otid(), lane = tid & 63, wave = tid >> 6;
    const int gw = blockIdx.x * 8 + wave, NGW = gridDim.x * 8;
    const int gt = blockIdx.x * 512 + tid, NGT = gridDim.x * 512;
    unsigned char* ws = a.ws;
    float* scr = (float*)(lds + wave * 16384);
    { float* rp = (float*)(ws + WS_ROPE);
      for (int i = gt; i < SEQ * 8; i += NGT) { const int pos = i >> 3, k = i & 7;
          const double invf = (k == 0) ? 1.0 : (k == 1) ? 0.19392274474868576 : (k == 2) ? 0.03760603093086393 : (k == 3) ? 0.007292664737217109 : (k == 4) ? 0.001414213562373095 : (k == 5) ? 0.0002742481756762073 : (k == 6) ? 5.318295896944988e-05 : 1.031338537721246e-05;
          const double rev = (double)pos * invf * 0.15915494309189535; const float fr = (float)(rev - rint(rev));
          rp[2 * i] = __builtin_amdgcn_cosf(fr); rp[2 * i + 1] = __builtin_amdgcn_sinf(fr); } }
    { float* cwp = (float*)(ws + WS_CWP);
      for (int i = gt; i < 4 * (DFF / 4) * 32; i += NGT) { const int e = i & 3, pp = (i >> 2) & 7, q = (i >> 5) % (DFF / 4), L = i / ((DFF / 4) * 32);
          const int j = 4 * q + e + ((pp >= 4) ? DFF : 0), p3 = pp & 3;
          cwp[i] = (p3 < 3) ? a.in[18][((size_t)L * 3 + p3) * DFF2 + j] : a.in[19][(size_t)L * DFF2 + j]; } }
    { float* swp = (float*)(ws + WS_SWP);
      for (int i = gt; i < 2 * (CONVD / 4) * 24; i += NGT) { const int L = i / ((CONVD / 4) * 24), r = i - L * ((CONVD / 4) * 24), q = r / 24, pp = (r % 24) >> 2, e = r & 3, c = 4 * q + e;
          swp[i] = (pp < 5) ? a.in[9][((size_t)L * 5 + pp) * CONVD + c] : a.in[10][(size_t)L * CONVD + c]; } }
    { u32x4* gz = (u32x4*)(ws + WS_XB - 2 * DM * 2); for (int i = gt; i < 2 * DM * 2 / 16; i += NGT) gz[i] = (u32x4){0u, 0u, 0u, 0u}; }
    { const float* x = a.in[0]; bf16* xb = (bf16*)(ws + WS_XB); float* ss = (float*)(ws + WS_SS);
      for (int m = gw; m < MTOK; m += NGW) { const f32x4* xr = (const f32x4*)(x + (size_t)m * DM) + lane; float s = 0.f;
          unsigned long long* o8 = (unsigned long long*)(xb + (size_t)m * DM) + lane;
#pragma unroll
          for (int j = 0; j < 4; ++j) { const f32x4 v = __builtin_nontemporal_load(&xr[64 * j]); s += (v.x * v.x + v.y * v.y) + (v.z * v.z + v.w * v.w);
              o8[64 * j] = (unsigned long long)pk2(v.x, v.y) | ((unsigned long long)pk2(v.z, v.w) << 32); }
          s = wave_sum(s); if (lane < 4) ss[(size_t)m * 4 + lane] = (lane == 0) ? s : 0.f; } }
    for (int j = 0; j < 2; ++j) {
        p0_matrix(a.in[2] + (size_t)j * DM * QKVD, a.in[1] + j * DM, DM, QKVD, (bf16*)(ws + WS_W + j * W_ATT_STRIDE), scr, gw, NGW, lane);
        p0_matrix(a.in[6] + (size_t)j * DM * DM, nullptr, DM, DM, (bf16*)(ws + WS_W + j * W_ATT_STRIDE + W_ATT_WO), scr, gw, NGW, lane);
        bf16* win = (bf16*)(ws + WS_W + W_SSD0 + j * W_SSD_STRIDE);
        p0_matrix(a.in[8] + (size_t)j * DM * SSDIN, a.in[7] + j * DM, DM, SSDIN, win, scr, gw, NGW, lane);
        { u32x4* z = (u32x4*)(win + (size_t)SSDIN * DM); const int n16 = (SSDINP - SSDIN) * DM * 2 / 16; for (int i = gt; i < n16; i += NGT) z[i] = (u32x4){0u, 0u, 0u, 0u}; }
        p0_matrix(a.in[15] + (size_t)j * DIN * DM, nullptr, DIN, DM, (bf16*)(ws + WS_W + W_SSD0 + j * W_SSD_STRIDE + W_SSD_WOUT), scr, gw, NGW, lane);
    }
    for (int i = 0; i < 4; ++i) {
        p0_matrix(a.in[17] + (size_t)i * DM * DFF2, a.in[16] + i * DM, DM, DFF2, (bf16*)(ws + WS_W + W_FFN0 + i * W_FFN_STRIDE), scr, gw, NGW, lane, 1);
        p0_matrix(a.in[20] + (size_t)i * DFF * DM, nullptr, DFF, DM, (bf16*)(ws + WS_W + W_FFN0 + i * W_FFN_STRIDE + W_FFN_DOWN), scr, gw, NGW, lane);
    }
}

#define LAS3 __attribute__((address_space(3)))
typedef short v4i16_t __attribute__((ext_vector_type(4)));
typedef float f32x16 __attribute__((ext_vector_type(16)));
typedef pg8::bf16x8 bf16x8;
constexpr int AT_RS = 144, AT_SK = 0, AT_SV = 384 * 144;
__device__ __forceinline__ void attn_phase(unsigned char* lds_g, const bf16* QKV, bf16* OB, const float* qg, const float* kg, const float* sink, const float* rope) {
    LAS3 unsigned char* lds = (LAS3 unsigned char*)lds_g;
    const int tid = otid(), lane = tid & 63, wave = __builtin_amdgcn_readfirstlane(tid >> 6);
    const int hi = lane >> 5, l32 = lane & 31, blk = (lane >> 4) & 1, q4 = (lane & 15) >> 2, p4 = lane & 3;
    constexpr float LOG2E = 1.4426950408889634f;
    for (int u = blockIdx.x; u < 1024; u += gridDim.x) {
        const int kvh = u & 3, n = (u >> 2) & 63, b = u >> 8;
        __syncthreads();
        { const int sub = tid & 7, r = tid >> 3;
          float kgv[8];
#pragma unroll
          for (int i = 0; i < 8; ++i) kgv[i] = kg[sub * 8 + i];
          u32x4 krs[6], vrs[6];
#pragma unroll
          for (int pass = 0; pass < 6; ++pass) { const int kpos = n * 128 - 128 + pass * 64 + r; const int kc = kpos < 0 ? 0 : (kpos >= SEQ ? SEQ - 1 : kpos);
              const size_t grow = (size_t)b * SEQ + kc;
              krs[pass] = *(const u32x4*)(QKV + grow * QKVD + 1024 + kvh * 64 + sub * 8);
              vrs[pass] = *(const u32x4*)(QKV + grow * QKVD + 1280 + kvh * 64 + sub * 8); }
#pragma unroll
          for (int pass = 0; pass < 6; ++pass) {
              const int jrow = pass * 64 + r, kpos = n * 128 - 128 + jrow;
              if (kpos >= 0 && kpos < SEQ) {
                  const u32x4 kr = krs[pass], vr = vrs[pass];
                  float k[8]; k[0] = bflo(kr.x); k[1] = bfhi(kr.x); k[2] = bflo(kr.y); k[3] = bfhi(kr.y); k[4] = bflo(kr.z); k[5] = bfhi(kr.z); k[6] = bflo(kr.w); k[7] = bfhi(kr.w);
                  float ss = 0.f;
#pragma unroll
                  for (int i = 0; i < 8; ++i) ss += k[i] * k[i];
                  ss += __shfl_xor(ss, 1); ss += __shfl_xor(ss, 2); ss += __shfl_xor(ss, 4);
                  const float rs = rsqrtf(ss * (1.0f / 64.0f) + EPSF);
#pragma unroll
                  for (int i = 0; i < 8; ++i) k[i] = k[i] * rs * kgv[i];
                  if (sub < 2) {
                      const float* rp = rope + (size_t)kpos * 16;
#pragma unroll
                      for (int i = 0; i < 8; ++i) { const float oth = __shfl_xor(k[i], 1); const float c = rp[2 * i], sn = rp[2 * i + 1];
                          k[i] = (sub == 0) ? (k[i] * c - oth * sn) : (k[i] * c + oth * sn); } }
                  u32x4 w; w.x = pk2(k[0], k[1]); w.y = pk2(k[2], k[3]); w.z = pk2(k[4], k[5]); w.w = pk2(k[6], k[7]);
                  *(LAS3 u32x4*)(lds + AT_SK + jrow * AT_RS + sub * 16) = w;
                  *(LAS3 u32x4*)(lds + AT_SV + jrow * AT_RS + sub * 16) = vr;
              }
          }
        }
        const int g = wave >> 1, head = kvh * 4 + g, i0 = 64 * (wave & 1);
        bf16x8 qf[2][4];
#pragma unroll
        for (int t = 0; t < 2; ++t) {
            const int qpos = n * 128 + i0 + 32 * t + l32; const size_t qrow = (size_t)b * SEQ + qpos;
            float qv[4][8]; float ss = 0.f;
#pragma unroll
            for (int ds = 0; ds < 4; ++ds) { const u32x4 w = *(const u32x4*)(QKV + qrow * QKVD + head * 64 + 16 * ds + 8 * hi);
                qv[ds][0] = bflo(w.x); qv[ds][1] = bfhi(w.x); qv[ds][2] = bflo(w.y); qv[ds][3] = bfhi(w.y); qv[ds][4] = bflo(w.z); qv[ds][5] = bfhi(w.z); qv[ds][6] = bflo(w.w); qv[ds][7] = bfhi(w.w);
#pragma unroll
                for (int jj = 0; jj < 8; ++jj) ss += qv[ds][jj] * qv[ds][jj]; }
            ss += __shfl_xor(ss, 32);
            const float rs = rsqrtf(ss * (1.0f / 64.0f) + EPSF);
#pragma unroll
            for (int ds = 0; ds < 4; ++ds)
#pragma unroll
                for (int jj = 0; jj < 8; ++jj) qv[ds][jj] = qv[ds][jj] * rs * qg[16 * ds + 8 * hi + jj];
            const float* rp = rope + (size_t)qpos * 16;
#pragma unroll
            for (int jj = 0; jj < 8; ++jj) { const float oth = __shfl_xor(qv[0][jj], 32); const float c = rp[2 * jj], sn = rp[2 * jj + 1];
                qv[0][jj] = hi ? (qv[0][jj] * c + oth * sn) : (qv[0][jj] * c - oth * sn); }
#pragma unroll
            for (int ds = 0; ds < 4; ++ds) { u32x4 w; const float sc = 0.125f * LOG2E;
                w.x = pk2(qv[ds][0] * sc, qv[ds][1] * sc); w.y = pk2(qv[ds][2] * sc, qv[ds][3] * sc); w.z = pk2(qv[ds][4] * sc, qv[ds][5] * sc); w.w = pk2(qv[ds][6] * sc, qv[ds][7] * sc);
                qf[t][ds] = __builtin_bit_cast(bf16x8, w); }
        }
        const float sink2 = sink[head] * LOG2E;
        float mrun[2] = {sink2, sink2}, lrun[2] = {hi ? 0.f : 1.f, hi ? 0.f : 1.f};
        f32x16 O[2][2];
#pragma unroll
        for (int t = 0; t < 2; ++t)
#pragma unroll
            for (int dt = 0; dt < 2; ++dt)
#pragma unroll
                for (int i = 0; i < 16; ++i) O[t][dt][i] = 0.f;
        __syncthreads();
        const int jlo = (n == 0) ? 128 : 0, jhi = (n == 63) ? 256 : 384;
        for (int jt = 0; jt < 10; ++jt) {
            const int jk = i0 + 32 * jt;
            if (jk < jlo || jk >= jhi) continue;
            bf16x8 kf[4], vf[2][2];
#pragma unroll
            for (int ds = 0; ds < 4; ++ds) kf[ds] = *(const LAS3 bf16x8*)(lds + AT_SK + (jk + l32) * AT_RS + (16 * ds + 8 * hi) * 2);
#pragma unroll
            for (int dt = 0; dt < 2; ++dt)
#pragma unroll
                for (int ks = 0; ks < 2; ++ks) {
                    const int off0 = (jk + 16 * ks + 4 * hi + q4) * AT_RS + (32 * dt + 16 * blk + 4 * p4) * 2;
                    const v4i16_t lo = __builtin_amdgcn_ds_read_tr16_b64_v4i16((LAS3 v4i16_t*)(lds + AT_SV + off0));
                    const v4i16_t hh = __builtin_amdgcn_ds_read_tr16_b64_v4i16((LAS3 v4i16_t*)(lds + AT_SV + off0 + 8 * AT_RS));
                    vf[dt][ks] = (bf16x8){lo[0], lo[1], lo[2], lo[3], hh[0], hh[1], hh[2], hh[3]};
                }
#pragma unroll
            for (int t = 0; t < 2; ++t) {
                if (jt < t || jt >= 9 + t) continue;
                f32x16 S;
#pragma unroll
                for (int i = 0; i < 16; ++i) S[i] = 0.f;
#pragma unroll
                for (int ds = 0; ds < 4; ++ds) S = __builtin_amdgcn_mfma_f32_32x32x16_bf16(kf[ds], qf[t][ds], S, 0, 0, 0);
                if (jt == t) {
#pragma unroll
                    for (int r = 0; r < 16; ++r) { const int kvrel = (r & 3) + 8 * (r >> 2) + 4 * hi; if (kvrel < l32) S[r] = -1e30f; }
                } else if (jt == t + 8) {
#pragma unroll
                    for (int r = 0; r < 16; ++r) { const int kvrel = (r & 3) + 8 * (r >> 2) + 4 * hi; if (kvrel > l32) S[r] = -1e30f; }
                }
                float tmax = S[0];
#pragma unroll
                for (int r = 1; r < 16; ++r) tmax = fmaxf(tmax, S[r]);
                tmax = fmaxf(tmax, __shfl_xor(tmax, 32));
                if (__any(tmax > mrun[t])) {
                    const float mnew = fmaxf(mrun[t], tmax), corr = __builtin_amdgcn_exp2f(mrun[t] - mnew);
                    lrun[t] *= corr; mrun[t] = mnew;
#pragma unroll
                    for (int dt = 0; dt < 2; ++dt)
#pragma unroll
                        for (int i = 0; i < 16; ++i) O[t][dt][i] *= corr;
                }
                float ps = 0.f;
#pragma unroll
                for (int r = 0; r < 16; ++r) { S[r] = __builtin_amdgcn_exp2f(S[r] - mrun[t]); ps += S[r]; }
                lrun[t] += ps;
#pragma unroll
                for (int ks = 0; ks < 2; ++ks) {
                    u32x4 w; w.x = pk2(S[8 * ks], S[8 * ks + 1]); w.y = pk2(S[8 * ks + 2], S[8 * ks + 3]); w.z = pk2(S[8 * ks + 4], S[8 * ks + 5]); w.w = pk2(S[8 * ks + 6], S[8 * ks + 7]);
                    const bf16x8 pb = __builtin_bit_cast(bf16x8, w);
#pragma unroll
                    for (int dt = 0; dt < 2; ++dt) O[t][dt] = __builtin_amdgcn_mfma_f32_32x32x16_bf16(vf[dt][ks], pb, O[t][dt], 0, 0, 0);
                }
            }
        }
#pragma unroll
        for (int t = 0; t < 2; ++t) {
            const float ltot = lrun[t] + __shfl_xor(lrun[t], 32), il = 1.f / ltot;
            const size_t qrow = (size_t)b * SEQ + n * 128 + i0 + 32 * t + l32;
#pragma unroll
            for (int dt = 0; dt < 2; ++dt)
#pragma unroll
                for (int i4 = 0; i4 < 4; ++i4) { u32x2 w; w.x = pk2(O[t][dt][4 * i4] * il, O[t][dt][4 * i4 + 1] * il); w.y = pk2(O[t][dt][4 * i4 + 2] * il, O[t][dt][4 * i4 + 3] * il);
                    *(u32x2*)(OB + qrow * DM + head * 64 + 32 * dt + 8 * i4 + 4 * hi) = w; }
        }
    }
}

__device__ __forceinline__ void ld8(const bf16* p, float (&v)[8]) { const u32x4 w = *(const u32x4*)p; v[0] = bflo(w.x); v[1] = bfhi(w.x); v[2] = bflo(w.y); v[3] = bfhi(w.y); v[4] = bflo(w.z); v[5] = bfhi(w.z); v[6] = bflo(w.w); v[7] = bfhi(w.w); }
__device__ __forceinline__ void ldf8(const float* p, float (&v)[8]) { const f32x4 a = *(const f32x4*)p, b = *(const f32x4*)(p + 4); v[0] = a.x; v[1] = a.y; v[2] = a.z; v[3] = a.w; v[4] = b.x; v[5] = b.y; v[6] = b.z; v[7] = b.w; }
__device__ __forceinline__ void st8(bf16* p, const float (&v)[8]) { u32x4 w; w.x = pk2(v[0], v[1]); w.y = pk2(v[2], v[3]); w.z = pk2(v[4], v[5]); w.w = pk2(v[6], v[7]); *(u32x4*)p = w; }

__device__ __forceinline__ void fconv_phase(const bf16* H, bf16* ACT, const float* cw, const float* cb) {
    const int gt = blockIdx.x * 512 + otid(), NGT = gridDim.x * 512;
    constexpr int NCG = DFF / 8, NITEMS = (MH / 8) * NCG;
    for (int it = gt; it < NITEMS; it += NGT) {
        const int cgx = it % NCG, run = it / NCG, r0 = run * 8, t0 = r0 & (SEQ - 1), j0 = cgx * 8;
        float wg[3][8], wv[3][8], bg[8], bv[8];
#pragma unroll
        for (int k = 0; k < 3; ++k) { ldf8(cw + k * DFF2 + j0, wg[k]); ldf8(cw + k * DFF2 + DFF + j0, wv[k]); }
        ldf8(cb + j0, bg); ldf8(cb + DFF + j0, bv);
        float gm[8], g0[8], gp[8], vm[8], v0[8], vp[8];
        const bf16* hp = H + (size_t)r0 * DFF2 + j0;
        if (t0 > 0) { ld8(hp - DFF2, gm); ld8(hp - DFF2 + DFF, vm); } else {
#pragma unroll
            for (int c = 0; c < 8; ++c) { gm[c] = 0.f; vm[c] = 0.f; } }
        ld8(hp, g0); ld8(hp + DFF, v0);
#pragma unroll
        for (int i = 0; i < 8; ++i) {
            if (i < 7 || t0 + 8 < SEQ) { ld8(hp + (size_t)(i + 1) * DFF2, gp); ld8(hp + (size_t)(i + 1) * DFF2 + DFF, vp); } else {
#pragma unroll
                for (int c = 0; c < 8; ++c) { gp[c] = 0.f; vp[c] = 0.f; } }
            float o[8];
#pragma unroll
            for (int c = 0; c < 8; ++c) { const float G = bg[c] + wg[0][c] * gm[c] + wg[1][c] * g0[c] + wg[2][c] * gp[c]; const float V = bv[c] + wv[0][c] * vm[c] + wv[1][c] * v0[c] + wv[2][c] * vp[c]; o[c] = siluf(G) * V; }
            st8(ACT + (size_t)(r0 + i) * DFF + j0, o);
#pragma unroll
            for (int c = 0; c < 8; ++c) { gm[c] = g0[c]; g0[c] = gp[c]; vm[c] = v0[c]; v0[c] = vp[c]; }
        }
    }
}

__device__ __forceinline__ void sconv_phase(const bf16* RAW, bf16* CONV, float* DT, const float* cw, const float* cb, const float* dtb) {
    const int gt = blockIdx.x * 512 + otid(), NGT = gridDim.x * 512;
    constexpr int NCG = CONVD / 8, NITEMS = (MH / 8) * NCG;
    for (int it = gt; it < NITEMS; it += NGT) {
        const int cgx = it % NCG, run = it / NCG, r0 = run * 8, t0 = r0 & (SEQ - 1), j0 = cgx * 8;
        float w[5][8], bb[8];
#pragma unroll
        for (int k = 0; k < 5; ++k) ldf8(cw + k * CONVD + j0, w[k]);
        ldf8(cb + j0, bb);
        float win[5][8];
        const bf16* hp = RAW + (size_t)r0 * CONVD + j0;
#pragma unroll
        for (int k = 0; k < 4; ++k) { const int dt_ = k - 2;
            if (t0 + dt_ >= 0) ld8(hp + (ptrdiff_t)dt_ * CONVD, win[k]); else {
#pragma unroll
                for (int c = 0; c < 8; ++c) win[k][c] = 0.f; } }
#pragma unroll
        for (int i = 0; i < 8; ++i) {
            if (t0 + i + 2 < SEQ) ld8(hp + (size_t)(i + 2) * CONVD, win[4]); else {
#pragma unroll
                for (int c = 0; c < 8; ++c) win[4][c] = 0.f; }
            float o[8];
#pragma unroll
            for (int c = 0; c < 8; ++c) { const float v = bb[c] + w[0][c] * win[0][c] + w[1][c] * win[1][c] + w[2][c] * win[2][c] + w[3][c] * win[3][c] + w[4][c] * win[4][c]; o[c] = siluf(v); }
            st8(CONV + (size_t)(r0 + i) * CONVD + j0, o);
#pragma unroll
            for (int k = 0; k < 4; ++k)
#pragma unroll
                for (int c = 0; c < 8; ++c) win[k][c] = win[k + 1][c];
        }
    }
    for (int i = gt; i < MH * 64; i += NGT) { const float v = DT[i] + dtb[i & 63]; DT[i] = fmaxf(v, 0.f) + __logf(1.f + __expf(-fabsf(v))); }
}

constexpr int M2_RS = 272, M2_RSX = 80;
constexpr int M2_C = 0, M2_B = 34816, M2_M = 69632, M2_XDT = 104448, M2_XDEC = 114688, M2_S0 = 124928, M2_S1 = 133632, M2_E = 142336, M2_DTV = 142848, M2_TOT = 143360;
__device__ __forceinline__ bf16x8 tr_frag(LAS3 unsigned char* base, int off0, int rs) {
    const v4i16_t lo = __builtin_amdgcn_ds_read_tr16_b64_v4i16((LAS3 v4i16_t*)(base + off0));
    const v4i16_t hi = __builtin_amdgcn_ds_read_tr16_b64_v4i16((LAS3 v4i16_t*)(base + off0 + 4 * rs));
    return (bf16x8){lo[0], lo[1], lo[2], lo[3], hi[0], hi[1], hi[2], hi[3]};
}
__device__ __forceinline__ bf16 f2bf_s(float f) { return (bf16)(pk2(f, 0.f) & 0xffffu); }
#define M2_BAR() asm volatile("s_waitcnt lgkmcnt(0)\n\ts_barrier" ::: "memory")
__device__ __forceinline__ void march_scan(LAS3 unsigned char* sb_, const float* DT, size_t rbase, int col, float A, int dir, int lane) {
    LAS3 float* sE = (LAS3 float*)sb_; LAS3 float* sDt = (LAS3 float*)(sb_ + 512); LAS3 float* sTot = (LAS3 float*)(sb_ + 1024);
    const float dt0 = DT[(rbase + 2 * lane) * 64 + col], dt1 = DT[(rbase + 2 * lane + 1) * 64 + col];
    const float a0 = dt0 * A, a1 = dt1 * A, ps = a0 + a1; float inc = ps;
#pragma unroll
    for (int d = 1; d < 64; d <<= 1) { const float t = __shfl_up(inc, d); if (lane >= d) inc += t; }
    const float tot = __shfl(inc, 63);
    float e0 = inc - a1, e1 = inc;
    if (dir) { e0 = tot - e0 + a0; e1 = tot - e1 + a1; }
    constexpr float L2E = 1.4426950408889634f;
    sE[2 * lane] = e0 * L2E; sE[2 * lane + 1] = e1 * L2E; sDt[2 * lane] = dt0; sDt[2 * lane + 1] = dt1;
    if (lane == 0) sTot[0] = tot * L2E;
}
__device__ __forceinline__ void march_phase(unsigned char* lds_g, const bf16* CONV, const float* DT, bf16* YF, bf16* YB, const float* alog) {
    LAS3 unsigned char* lds = (LAS3 unsigned char*)lds_g;
    const int tid = otid(), lane = tid & 63, wave = __builtin_amdgcn_readfirstlane(tid >> 6);
    const int h = lane >> 5, l32 = lane & 31, blk = (lane >> 4) & 1, q4 = (lane & 15) >> 2, p4 = lane & 3;
    constexpr int SCAN_STRIDE = 1040;
    for (int it = blockIdx.x; it < 256; it += gridDim.x) {
        const int xcd = it & 7, slot = it >> 3, set = xcd * 4 + (slot >> 3), mem = slot & 7;
        const int bl = set >> 4, grp = (set >> 1) & 7, dir = set & 1, head = grp * 4 + (mem >> 1), ph = mem & 1;
        const float A = -__expf(alog[dir * 32 + head]);
        bf16* Y = dir ? YB : YF;
        f32x16 Sacc;
#pragma unroll
        for (int i = 0; i < 16; ++i) Sacc[i] = 0.f;
        __syncthreads();
        for (int i = tid; i < 8704 / 16; i += 512) *(LAS3 u32x4*)(lds + M2_S0 + i * 16) = (u32x4){0u, 0u, 0u, 0u};
        u32x4 rc[4], rb[4], rx;
        {   const size_t rbase = (size_t)bl * SEQ + (size_t)(dir ? 63 : 0) * 128;
#pragma unroll
            for (int q = 0; q < 4; ++q) { const int idx = tid + 512 * q, row = idx >> 4, part = idx & 15;
                const bf16* bc = CONV + (size_t)2048 * MH + ((size_t)grp * MH + rbase + row) * 256 + part * 8;
                rb[q] = *(const u32x4*)bc; rc[q] = *(const u32x4*)(bc + 128); }
            rx = *(const u32x4*)(CONV + ((size_t)(head * 2 + ph) * MH + rbase + (tid >> 2)) * 32 + (tid & 3) * 8);
            if (wave == 4) march_scan(lds + M2_E, DT, rbase, dir * 32 + head, A, dir, lane);
        }
        for (int ci = 0; ci < 64; ++ci) {
            const int c = dir ? (63 - ci) : ci;
            const size_t rbase = (size_t)bl * SEQ + (size_t)c * 128;
            LAS3 unsigned char* scb = lds + M2_E + (ci & 1) * SCAN_STRIDE;
            LAS3 float* sE = (LAS3 float*)scb; LAS3 float* sDt = (LAS3 float*)(scb + 512);
            M2_BAR();
#pragma unroll
            for (int q = 0; q < 4; ++q) { const int idx = tid + 512 * q, row = idx >> 4, part = idx & 15;
                *(LAS3 u32x4*)(lds + M2_C + row * M2_RS + part * 16) = rc[q];
                *(LAS3 u32x4*)(lds + M2_B + row * M2_RS + part * 16) = rb[q]; }
            const float tot = *(LAS3 float*)(scb + 1024);
            {   const int row = tid >> 2, part = tid & 3; const float dtv = sDt[row], f2 = dtv * __builtin_amdgcn_exp2f(tot - sE[row]);
                float xv[8]; xv[0] = bflo(rx.x); xv[1] = bfhi(rx.x); xv[2] = bflo(rx.y); xv[3] = bfhi(rx.y); xv[4] = bflo(rx.z); xv[5] = bfhi(rx.z); xv[6] = bflo(rx.w); xv[7] = bfhi(rx.w);
                u32x4 w1, w2;
                w1.x = pk2(xv[0] * dtv, xv[1] * dtv); w1.y = pk2(xv[2] * dtv, xv[3] * dtv); w1.z = pk2(xv[4] * dtv, xv[5] * dtv); w1.w = pk2(xv[6] * dtv, xv[7] * dtv);
                w2.x = pk2(xv[0] * f2, xv[1] * f2); w2.y = pk2(xv[2] * f2, xv[3] * f2); w2.z = pk2(xv[4] * f2, xv[5] * f2); w2.w = pk2(xv[6] * f2, xv[7] * f2);
                *(LAS3 u32x4*)(lds + M2_XDT + row * M2_RSX + part * 16) = w1;
                *(LAS3 u32x4*)(lds + M2_XDEC + row * M2_RSX + part * 16) = w2; }
            M2_BAR();
            const int cn = dir ? (62 - ci) : (ci + 1); const size_t rb2 = (size_t)bl * SEQ + (size_t)cn * 128;
            if (ci + 1 < 64) {
#pragma unroll
                for (int q = 0; q < 4; ++q) { const int idx = tid + 512 * q, row = idx >> 4, part = idx & 15;
                    const bf16* bc = CONV + (size_t)2048 * MH + ((size_t)grp * MH + rb2 + row) * 256 + part * 8;
                    rb[q] = *(const u32x4*)bc; rc[q] = *(const u32x4*)(bc + 128); }
                rx = *(const u32x4*)(CONV + ((size_t)(head * 2 + ph) * MH + rb2 + (tid >> 2)) * 32 + (tid & 3) * 8);
            }
            for (int rep1 = 0; rep1 < (MPROBE == 1 ? 2 : 1); ++rep1)
            {
                const int sh4 = 4 * wave, rbF = (0x02101233 >> sh4) & 15, c0F = (0x02001020 >> sh4) & 15, ntl = (0x01111222 >> sh4) & 15;
                const int rbk = dir ? 3 - rbF : rbF, cb0 = dir ? ((ntl == 2 ? 2 : 3) - c0F) : c0F;
                const bool need0 = ntl >= 1, need1 = ntl >= 2;
                f32x16 g0, g1;
#pragma unroll
                for (int i = 0; i < 16; ++i) { g0[i] = 0.f; g1[i] = 0.f; }
                if (need0 || need1) {
#pragma unroll
                    for (int kk = 0; kk < 8; ++kk) {
                        const bf16x8 av = *(const LAS3 bf16x8*)(lds + M2_C + (32 * rbk + l32) * M2_RS + (16 * kk + 8 * h) * 2);
                        if (need0) { const bf16x8 bv = *(const LAS3 bf16x8*)(lds + M2_B + (32 * cb0 + l32) * M2_RS + (16 * kk + 8 * h) * 2); g0 = __builtin_amdgcn_mfma_f32_32x32x16_bf16(av, bv, g0, 0, 0, 0); }
                        if (need1) { const bf16x8 bv = *(const LAS3 bf16x8*)(lds + M2_B + (32 * (cb0 + 1) + l32) * M2_RS + (16 * kk + 8 * h) * 2); g1 = __builtin_amdgcn_mfma_f32_32x32x16_bf16(av, bv, g1, 0, 0, 0); }
                    }
                }
                int oz = 0; asm volatile("" : "+v"(oz));
                const int s0 = 32 * cb0 + l32 + oz, s1 = s0 + 32;
#pragma unroll
                for (int t = 0; t < 2; ++t) {
                    const bool need = t ? need1 : need0; const int sc = t ? s1 : s0; const bool diag = (cb0 + t) == rbk;
                    LAS3 unsigned char* mrow = lds + M2_M + sc * M2_RS + (32 * rbk + 4 * h) * 2;
                    if (need) {
                        const float Es = sE[sc];
#pragma unroll
                        for (int i4 = 0; i4 < 4; ++i4) {
                            float v[4];
#pragma unroll
                            for (int e = 0; e < 4; ++e) { const int i = 4 * i4 + e, l = 32 * rbk + 8 * i4 + 4 * h + e;
                                const float gg = t ? g1[i] : g0[i]; float x = gg * __builtin_amdgcn_exp2f(sE[l] - Es);
                                if (diag) { const bool ok = dir ? (sc >= l) : (sc <= l); x = ok ? x : 0.f; }
                                v[e] = x; }
                            u32x2 w; w.x = pk2(v[0], v[1]); w.y = pk2(v[2], v[3]);
                            *(LAS3 u32x2*)(mrow + 16 * i4) = w;
                        }
                    }
                }
            }
            M2_BAR();
            LAS3 unsigned char* sScur = lds + ((ci & 1) ? M2_S1 : M2_S0); LAS3 unsigned char* sSnxt = lds + ((ci & 1) ? M2_S0 : M2_S1);
            for (int rep2 = 0; rep2 < (MPROBE == 2 ? 2 : 1); ++rep2)
            if (wave < 4) {
                const int l0 = 32 * wave;
                f32x16 yd, yo;
#pragma unroll
                for (int i = 0; i < 16; ++i) { yd[i] = 0.f; yo[i] = 0.f; }
                const int klo = dir ? 2 * wave : 0, khi = dir ? 8 : 2 * (wave + 1);
#pragma unroll
                for (int kk = 0; kk < 8; ++kk) {
                    if (kk >= klo && kk < khi) {
                        const bf16x8 av = tr_frag(lds + M2_M, (16 * kk + 8 * h + q4) * M2_RS + (l0 + 16 * blk + 4 * p4) * 2, M2_RS);
                        const bf16x8 bv = tr_frag(lds + M2_XDT, (16 * kk + 8 * h + q4) * M2_RSX + (16 * blk + 4 * p4) * 2, M2_RSX);
                        yd = __builtin_amdgcn_mfma_f32_32x32x16_bf16(av, bv, yd, 0, 0, 0); }
                    const bf16x8 av2 = *(const LAS3 bf16x8*)(lds + M2_C + (l0 + l32) * M2_RS + (16 * kk + 8 * h) * 2);
                    const bf16x8 bv2 = *(const LAS3 bf16x8*)(sScur + l32 * M2_RS + (16 * kk + 8 * h) * 2);
                    yo = __builtin_amdgcn_mfma_f32_32x32x16_bf16(av2, bv2, yo, 0, 0, 0);
                }
#pragma unroll
                for (int i = 0; i < 16; ++i) { const int l = l0 + 8 * (i >> 2) + 4 * h + (i & 3);
                    const float y = yd[i] + __builtin_amdgcn_exp2f(sE[l]) * yo[i];
                    Y[(rbase + l) * DIN + head * 64 + ph * 32 + l32] = f2bf_s(y); }
            } else {
                const int n0 = 32 * (wave - 4);
                const float et = __builtin_amdgcn_exp2f(tot);
#pragma unroll
                for (int i = 0; i < 16; ++i) Sacc[i] *= et;
#pragma unroll
                for (int kk = 0; kk < 8; ++kk) {
                    const bf16x8 av = tr_frag(lds + M2_XDEC, (16 * kk + 8 * h + q4) * M2_RSX + (16 * blk + 4 * p4) * 2, M2_RSX);
                    const bf16x8 bv = tr_frag(lds + M2_B, (16 * kk + 8 * h + q4) * M2_RS + (n0 + 16 * blk + 4 * p4) * 2, M2_RS);
                    Sacc = __builtin_amdgcn_mfma_f32_32x32x16_bf16(av, bv, Sacc, 0, 0, 0);
                }
#pragma unroll
                for (int i4 = 0; i4 < 4; ++i4)
#pragma unroll
                    for (int e = 0; e < 4; ++e) { const int p = 8 * i4 + 4 * h + e;
                        *(LAS3 bf16*)(sSnxt + p * M2_RS + (n0 + l32) * 2) = f2bf_s(Sacc[4 * i4 + e]); }
                if (wave == 4 && ci + 1 < 64) march_scan(lds + M2_E + ((ci + 1) & 1) * SCAN_STRIDE, DT, rb2, dir * 32 + head, A, dir, lane);
            }
        }
        asm volatile("s_waitcnt vmcnt(0)" ::: "memory");
    }
}

__device__ __forceinline__ void comb_phase(bf16* Z, const bf16* YF, const bf16* YB, const float* gg, const bf16* CONV, const float* dsk) {
    const int tid = otid(), lane = tid & 63, wave = tid >> 6;
    const int gw = blockIdx.x * 8 + wave, NGW = gridDim.x * 8;
    for (int it = gw; it < MH * 8; it += NGW) {
        const int g = it & 7, r = it >> 3; const size_t off = (size_t)r * DIN + g * 256 + 4 * lane;
        const u32x2 a = __builtin_nontemporal_load((const u32x2*)(YF + off)), b = __builtin_nontemporal_load((const u32x2*)(YB + off)), z = *(const u32x2*)(Z + off);
        const int cx = g * 256 + 4 * lane; const u32x2 xr = *(const u32x2*)(CONV + ((size_t)(cx >> 5) * MH + r) * 32 + (cx & 31)); const float dh = dsk[g * 4 + (lane >> 4)];
        float y[4];
        y[0] = (bflo(a.x) + bflo(b.x) + dh * bflo(xr.x)) * siluf(bflo(z.x)); y[1] = (bfhi(a.x) + bfhi(b.x) + dh * bfhi(xr.x)) * siluf(bfhi(z.x));
        y[2] = (bflo(a.y) + bflo(b.y) + dh * bflo(xr.y)) * siluf(bflo(z.y)); y[3] = (bfhi(a.y) + bfhi(b.y) + dh * bfhi(xr.y)) * siluf(bfhi(z.y));
        const float ss = wave_sum((y[0] * y[0] + y[1] * y[1]) + (y[2] * y[2] + y[3] * y[3]));
        const float rs = rsqrtf(ss * (1.0f / 256.0f) + EPSF);
        const f32x4 gv = *(const f32x4*)(gg + g * 256 + 4 * lane);
        u32x2 w; w.x = pk2(y[0] * rs * gv.x, y[1] * rs * gv.y); w.y = pk2(y[2] * rs * gv.z, y[3] * rs * gv.w);
        *(u32x2*)(Z + off) = w;
    }
}

#define LAS __attribute__((address_space(3)))
#define XB_TMO      128
#define XB_XCNT(j)  (256  + 64 * (j))
#define XB_XSUB(j)  (1280 + 64 * (j))
#define XB_XGEN(j)  (2304 + 64 * (j))
#define XB_TOP      3328
#define XB_TOPGEN   3392
#define XCD_BAR_WORDS 3456
#define XB_SPIN_CAP (1u << 18)

__device__ __forceinline__ unsigned xb_ld(unsigned* p)              { return __hip_atomic_load(p, __ATOMIC_RELAXED, __HIP_MEMORY_SCOPE_AGENT); }
__device__ __forceinline__ unsigned xb_add(unsigned* p, unsigned v) { return __hip_atomic_fetch_add(p, v, __ATOMIC_RELAXED, __HIP_MEMORY_SCOPE_AGENT); }
__device__ __forceinline__ unsigned xb_xcc_id() { return (unsigned)__builtin_amdgcn_s_getreg((3 << 11) | 20) & 0xFu; }
#define XB_SPIN(cond, bar) do { unsigned _sp = 0; while (cond) { __builtin_amdgcn_s_sleep(1); \
    if ((++_sp & 255u) == 0u) { if (xb_ld(&(bar)[XB_TMO])) break; if (_sp > XB_SPIN_CAP) { atomicAdd(&(bar)[XB_TMO], 1u); break; } } } } while (0)

struct XcdBarrier {
    unsigned* bar; unsigned x;
    volatile LAS unsigned* st;
};

__device__ __forceinline__ XcdBarrier xcd_barrier_post(unsigned* bar, volatile LAS unsigned* st) {
    XcdBarrier b; b.bar = bar; b.x = xb_xcc_id(); b.st = st;
    if (threadIdx.x == 0) (void)xb_add(&bar[XB_XCNT(b.x)], 1u);
    return b;
}
__device__ __forceinline__ void xcd_barrier_complete(unsigned* bar, unsigned x, unsigned& nloc, unsigned& nx) {
    const unsigned G = gridDim.x * gridDim.y * gridDim.z;
    unsigned sum, cnt, mine, sp = 0u;
    for (;;) {
        sum = 0u; cnt = 0u; mine = 0u;
#pragma unroll
        for (unsigned j = 0; j < 16; ++j) { const unsigned c = xb_ld(&bar[XB_XCNT(j)]); sum += c; cnt += (c > 0u) ? 1u : 0u; mine = (j == x) ? c : mine; }
        if (sum == G) break;
        __builtin_amdgcn_s_sleep(1);
        if ((++sp & 255u) == 0u) { if (xb_ld(&bar[XB_TMO])) break; if (sp > XB_SPIN_CAP) { atomicAdd(&bar[XB_TMO], 1u); break; } }
    }
    nloc = mine > 0u ? mine : 1u; nx = cnt > 0u ? cnt : 1u;
}

__device__ __forceinline__ void xcd_barrier(const XcdBarrier& b) {
    asm volatile("s_waitcnt vmcnt(0)" ::: "memory");
    __syncthreads();
    if (threadIdx.x == 0) {
        unsigned* bar = b.bar;
        __builtin_amdgcn_s_waitcnt(0);
        unsigned nloc = b.st[0], nx = b.st[1];
        if (nloc == 0u) { xcd_barrier_complete(bar, b.x, nloc, nx); b.st[0] = nloc; b.st[1] = nx; }
        const unsigned old = xb_add(&bar[XB_XSUB(b.x)], 1u);
        const unsigned gen = old / nloc;
        if (old + 1u == (gen + 1u) * nloc) {
            __builtin_amdgcn_fence(__ATOMIC_RELEASE, "agent");
            asm volatile("s_waitcnt vmcnt(0)" ::: "memory");
            const unsigned og = xb_add(&bar[XB_TOP], 1u);
            const unsigned tg = og / nx;
            if (og + 1u == (tg + 1u) * nx) xb_add(&bar[XB_TOPGEN], 1u);
            else XB_SPIN(xb_ld(&bar[XB_TOPGEN]) == tg, bar);
            __builtin_amdgcn_fence(__ATOMIC_ACQUIRE, "agent");
            xb_add(&bar[XB_XGEN(b.x)], 1u);
            asm volatile("s_waitcnt vmcnt(0)" ::: "memory");
        } else {
            XB_SPIN(xb_ld(&bar[XB_XGEN(b.x)]) == gen, bar);
            __builtin_amdgcn_fence(__ATOMIC_ACQUIRE, "agent");
            asm volatile("s_waitcnt vmcnt(0)" ::: "memory");
        }
    }
    __syncthreads();
}

constexpr int LDS_BYTES = 147456;
__global__ void __launch_bounds__(512, 2) mega_fwd(Args a) {
    __shared__ __attribute__((aligned(16))) unsigned char lds[LDS_BYTES];
    if (a.nsteps < 0) cg::this_grid().sync();
    unsigned char* ws = a.ws;
    volatile LAS unsigned* bst = (volatile LAS unsigned*)((LAS unsigned char*)lds + 147456 - 16);
    if (threadIdx.x < 2) bst[threadIdx.x] = 0u;
    __syncthreads();
    const XcdBarrier gbar = xcd_barrier_post((unsigned*)(ws + WS_BAR), bst);
    phase0(a, lds);
    xcd_barrier(gbar);
    if (PROBE == 8) { phase0(a, lds); xcd_barrier(gbar); }
    float* SS = (float*)(ws + WS_SS);
    bf16* XB = (bf16*)(ws + WS_XB);
    const float* rope = (const float*)(ws + WS_ROPE);
    for (int s = 0; s < a.nsteps; ++s) {
        const Step st = a.steps[s];
        const int L = st.layer, j = L >> 1, hb = st.hb;
        const size_t rowoff = (size_t)hb * MH;
        if (st.kind == K_GEMM) {
            pg8::Gemm g; EP e;
            e.mode = 0; e.ss_in = nullptr; e.o0 = nullptr; e.ld0 = 0; e.c0 = 0; e.o1 = nullptr; e.ld1 = 0; e.c1 = 0; e.o2 = nullptr; e.ld2 = 0; e.c2 = 0; e.pad = 0;
            e.base = nullptr; e.out = nullptr; e.xb = nullptr; e.ss_out = nullptr; e.cw = nullptr; e.cb = nullptr;
            const int sub = st.sub;
            if (sub == 0) {
                g.A = XB; g.Bt = (const bf16*)(ws + WS_W + j * W_ATT_STRIDE); g.M = MTOK; g.N = QKVD; g.K = DM;
                e.ss_in = SS; e.o0 = (bf16*)(ws + R_QKV); e.ld0 = QKVD; e.c0 = QKVD; e.c1 = QKVD; e.c2 = QKVD;
            } else if (sub == 6) {
                g.A = XB; g.Bt = (const bf16*)(ws + WS_W + j * W_ATT_STRIDE); g.M = MTOK; g.N = QKVD; g.K = DM;
                e.mode = 4; e.o0 = (bf16*)(ws + WS_R + 160 * MiB); e.ld0 = QKVD;
            } else if (sub == 1) {
                g.A = (const bf16*)(ws + R_OB); g.Bt = (const bf16*)(ws + WS_W + j * W_ATT_STRIDE + W_ATT_WO); g.M = MTOK; g.N = DM; g.K = DM;
                e.mode = 1; e.out = nullptr; e.xb = XB; e.ss_out = SS;
            } else if (sub == 2) {
                g.A = XB + rowoff * DM; g.Bt = (const bf16*)(ws + WS_W + W_SSD0 + j * W_SSD_STRIDE); g.M = 68 * 256; g.N = SSDINP; g.K = DM;
                e.mode = 3; e.ss_in = SS + rowoff * 4; e.o0 = (bf16*)(ws + R_Z); e.o1 = (bf16*)(ws + R_CONV); e.o2 = (float*)(ws + R_DT);
                e.cw = (const float*)(ws + WS_SWP) + (size_t)j * (CONVD / 4) * 24; e.cb = a.in[11] + j * 64;
            } else if (sub == 3) {
                g.A = (const bf16*)(ws + R_Z); g.Bt = (const bf16*)(ws + WS_W + W_SSD0 + j * W_SSD_STRIDE + W_SSD_WOUT); g.M = MH; g.N = DM; g.K = DIN;
                e.mode = 1; e.out = nullptr; e.xb = XB + rowoff * DM; e.ss_out = SS + rowoff * 4;
            } else if (sub == 4) {
                g.A = XB; g.Bt = (const bf16*)(ws + WS_W + W_FFN0 + L * W_FFN_STRIDE); g.M = 132 * 256; g.N = DFF2; g.K = DM;
                e.mode = 2; e.ss_in = SS; e.o0 = (bf16*)(ws + R_ACT); e.cw = (const float*)(ws + WS_CWP) + (size_t)L * (DFF / 4) * 32; e.cb = nullptr;
            } else {
                g.A = (const bf16*)(ws + R_ACT); g.Bt = (const bf16*)(ws + WS_W + W_FFN0 + L * W_FFN_STRIDE + W_FFN_DOWN); g.M = MTOK; g.N = DM; g.K = DFF;
                e.mode = 1; e.out = (L == 3) ? a.out : nullptr; e.xb = XB; e.ss_out = SS;
            }
            PG8_LAS EP* epl = (PG8_LAS EP*)((PG8_LAS unsigned char*)lds + 131072);
            if (otid() == 0) { epl->mode = e.mode; epl->ld0 = e.ld0; epl->c0 = e.c0; epl->ld1 = e.ld1; epl->c1 = e.c1; epl->ld2 = e.ld2; epl->c2 = e.c2; epl->pad = 0;
                epl->ss_in = e.ss_in; epl->o0 = e.o0; epl->o1 = e.o1; epl->o2 = e.o2; epl->base = e.base; epl->out = e.out; epl->xb = e.xb; epl->ss_out = e.ss_out; epl->cw = e.cw; epl->cb = e.cb; }
            __syncthreads();
            EpiG E; E.ep = epl;
            pg8::StaticOrder S; S.init(g.M, g.N, (int)gridDim.x, (int)blockIdx.x);
            g.amode = (sub == 4) ? 1 : (sub == 2) ? 2 : 0;
            pg8::gemm_phase<EpiG, pg8::StaticOrder, true, true>((PG8_LAS unsigned char*)lds, g, S, E);
        } else if (st.kind == K_ATTN) {
            attn_phase(lds, (const bf16*)(ws + R_QKV), (bf16*)(ws + R_OB), a.in[3] + j * 64, a.in[4] + j * 64, a.in[5] + j * 16, rope);
        } else if (st.kind == K_FCONV) {
            ;
        } else if (st.kind == K_SCONV) {
            sconv_phase((const bf16*)(ws + R_RAW), (bf16*)(ws + R_CONV), (float*)(ws + R_DT), a.in[9] + (size_t)j * 5 * CONVD, a.in[10] + (size_t)j * CONVD, a.in[11] + j * 64);
        } else if (st.kind == K_MARCH) {
            march_phase(lds, (const bf16*)(ws + R_CONV), (const float*)(ws + R_DT), (bf16*)(ws + R_YF), (bf16*)(ws + R_YB), a.in[12] + j * 64);
        } else if (st.kind == K_COMB) {
            comb_phase((bf16*)(ws + R_Z), (const bf16*)(ws + R_YF), (const bf16*)(ws + R_YB), a.in[14] + (size_t)j * DIN, (const bf16*)(ws + R_CONV), a.in[13] + j * 32);
        }
        xcd_barrier(gbar);
    }
}

extern "C" void kernel_launch(void* const* d_in, const int* in_sizes, int n_in, void* d_out, int out_size, void* d_ws, size_t ws_size, hipStream_t stream) {
    static int grid = 0;
    if (grid == 0) {
        if (n_in != 21 || out_size != MTOK * DM || ws_size < WS_END) { fprintf(stderr, "kernel_launch: unexpected shapes (n_in %d out %d ws %zu)\n", n_in, out_size, ws_size); grid = -1; return; }
        int dev = 0, cus = 0, per_cu = 0;
        hipGetDevice(&dev); hipDeviceGetAttribute(&cus, hipDeviceAttributeMultiprocessorCount, dev);
        hipOccupancyMaxActiveBlocksPerMultiprocessor(&per_cu, (const void*)mega_fwd, 512, 0);
        if (per_cu < 1) per_cu = 1;
        grid = cus;
    }
    if (grid < 0) return;
    Args a{};
    for (int i = 0; i < 21; ++i) a.in[i] = (const float*)d_in[i];
    a.out = (float*)d_out; a.ws = (unsigned char*)d_ws;
    int n = 0;
    auto add = [&](int kind, int layer, int sub, int hb) { a.steps[n].kind = kind; a.steps[n].layer = layer; a.steps[n].sub = sub; a.steps[n].hb = hb; ++n; };
    for (int L = 0; L < 4; ++L) {
        if ((L & 1) == 0) { add(K_GEMM, L, 0, 0); if (PROBE == 5) add(K_GEMM, L, 0, 0); if (PROBE == 7) add(K_GEMM, L, 6, 0); add(K_ATTN, L, 0, 0); if (PROBE == 3) add(K_ATTN, L, 0, 0); add(K_GEMM, L, 1, 0); }
        else for (int hb = 0; hb < 2; ++hb) { add(K_GEMM, L, 2, hb); if (PROBE == 4) add(K_GEMM, L, 2, hb); add(K_MARCH, L, 0, hb); if (PROBE == 2) add(K_MARCH, L, 0, hb); add(K_COMB, L, 0, hb); add(K_GEMM, L, 3, hb); }
        add(K_GEMM, L, 4, 0); if (PROBE == 1) add(K_GEMM, L, 4, 0); add(K_GEMM, L, 5, 0);
        if (PROBE == 6) for (int r = 0; r < 8; ++r) add(99, L, 0, 0);
    }
    a.nsteps = n;
    if (hipMemsetAsync(d_ws, 0, 16384, stream) != hipSuccess) { fprintf(stderr, "memset of the barrier words failed\n"); return; }
    void* args[] = {&a};
    hipError_t e = hipLaunchCooperativeKernel((const void*)mega_fwd, dim3(grid), dim3(512), args, 0, stream);
    if (e != hipSuccess) fprintf(stderr, "cooperative launch failed: %s (grid %d)\n", hipGetErrorString(e), grid);
}
```

```cpp
#include <hip/hip_runtime.h>
#include <hip/hip_cooperative_groups.h>
#include <cstdio>
#include <cstdint>
namespace cg = cooperative_groups;
namespace pg8 {
#define PG8_LAS __attribute__((address_space(3)))
typedef unsigned short bf16_t;
typedef short bf16x8 __attribute__((ext_vector_type(8)));
typedef float f32x4 __attribute__((ext_vector_type(4)));
typedef unsigned u32x4 __attribute__((ext_vector_type(4)));
constexpr int BM = 256, BK = 64, HALF = 128, HTB = HALF * BK * 2  , STAGE_BYTES = 8 * HTB, NXCD = 8, WGM = 8;

__host__ __device__ __forceinline__ int lds_byte(int r, int c) { const int st = (r >> 4) * 2 + (c >> 5), rr = r & 15, cc = c & 31, ob = rr * 64 + cc * 2; return st * 1024 + (ob ^ (((ob >> 9) & 1) << 5)); }
__host__ __device__ __forceinline__ void stage_rc(int b, int& R, int& C) { const int st = b / 1024, sb = b % 1024, swz = sb ^ (((sb >> 9) & 1) << 5); R = (st >> 1) * 16 + swz / 64; C = (st & 1) * 32 + (swz % 64) / 2; }
__host__ __device__ __forceinline__ int perm32(int rho) { const int n = rho >> 4, i = rho & 15; return 8 * (i >> 2) + 4 * n + (i & 3); }

struct Unit { int pm, pn; };
struct Gemm { const bf16_t* A; const bf16_t* Bt; int M, N, K, amode; };

struct StaticOrder {
    int nM, nN, nwg, G, c;
    __host__ __device__ void init(int M, int N, int G_, int c_) { nM = M / BM; nN = N / BM; nwg = nM * nN; G = G_; c = c_; }
    __host__ __device__ bool next(int i, Unit& u) const {
        const long L = (long)i * G + c; if (L >= nwg) return false;
        int wgid = (int)L; { const int q = nwg / NXCD, r = nwg % NXCD, xcd = wgid % NXCD, off = wgid / NXCD; wgid = (xcd < r ? xcd * (q + 1) : r * (q + 1) + (xcd - r) * q) + off; }
        const int nig = WGM * nN, gid = wgid / nig, fm = gid * WGM, gsz = (nM - fm) < WGM ? (nM - fm) : WGM;
        u.pm = fm + ((wgid % nig) % gsz); u.pn = (wgid % nig) / gsz; return true;
    }
    __device__ __forceinline__ void a_ready(const Unit&) const {}
    __device__ __forceinline__ void done(const Unit&) const {}
};


__device__ __forceinline__ unsigned cvt_pk_bf16(float lo, float hi) { unsigned r; asm volatile("v_cvt_pk_bf16_f32 %0, %1, %2" : "=v"(r) : "v"(lo), "v"(hi)); return r; }
template <class Epi, class Sched, bool ALIGN_EPI = false, bool SP2 = false>
__device__ __forceinline__ void gemm_phase(PG8_LAS unsigned char* lds, const Gemm g, const Sched& S, const Epi& E) {
    int tid_ = threadIdx.x; asm volatile("" : "+v"(tid_)); const int tid = tid_, wid = __builtin_amdgcn_readfirstlane(tid >> 6), lane = tid & 63, wr = wid >> 2, wc = wid & 3, fr = lane & 15, fq = lane >> 4;
    const int K = g.K, nt = K / BK;
    unsigned voffA[2], voffB[2];
#pragma unroll
    for (int i = 0; i < 2; ++i) { int R, C; stage_rc(tid * 16 + i * 8192, R, C); const int Rb = Epi::PERM ? ((R & ~31) + perm32(R & 31)) : R;
        const int Ra = (g.amode != 0) ? (((R >> 6) ? (g.amode == 2 ? 124 : 126) : 0) + 8 * (R & 15) + ((R >> 4) & 3)) : R;
        voffA[i] = (unsigned)(Ra * K + C) * 2u; voffB[i] = (unsigned)(Rb * K + C) * 2u; }
    const size_t kstep = (size_t)(BK * 2);
    const size_t hstep = (size_t)HALF * K * 2;
    const size_t tstep = 2 * hstep;
    const size_t hstepA = (g.amode != 0) ? (size_t)4 * K * 2 : hstep;
#define PG8_ABASE(pm_) ((g.amode == 1) ? ((const char*)g.A + ((ptrdiff_t)((pm_) / 33) * 8192 + (ptrdiff_t)((pm_) % 33) * 252 - 1) * (ptrdiff_t)K * 2) : (g.amode == 2) ? ((const char*)g.A + ((ptrdiff_t)((pm_) / 34) * 8192 + (ptrdiff_t)((pm_) % 34) * 248 - 2) * (ptrdiff_t)K * 2) : ((const char*)g.A + (size_t)(pm_) * tstep))
    const unsigned ldsw = (unsigned)wid * 1024u;
    const int aoff = lds_byte(wr * 64 + fr, fq * 8), boff = lds_byte(wc * 32 + fr, fq * 8);
#define PG8_SA(b, h) (((b) * 2 + (h)) * HTB)
#define PG8_SB(b, h) ((4 + (b) * 2 + (h)) * HTB)
#define PG8_STAGE(bufoff, gbase, voff) do { _Pragma("unroll") for (int _i = 0; _i < 2; ++_i) \
        __builtin_amdgcn_global_load_lds((const unsigned*)((const char*)(gbase) + (voff)[_i]), (PG8_LAS unsigned*)(lds + (bufoff) + ldsw + _i * 8192), 16, 0, 0); } while (0)
#define PG8_LDA(dst, b, h) do { _Pragma("unroll") for (int m = 0; m < 4; ++m) _Pragma("unroll") for (int k = 0; k < 2; ++k) dst[m][k] = *(const PG8_LAS bf16x8*)(lds + PG8_SA(b, h) + aoff + m * 2048 + k * 1024); } while (0)
#define PG8_LDB(dst, b, h) do { _Pragma("unroll") for (int n = 0; n < 2; ++n) _Pragma("unroll") for (int k = 0; k < 2; ++k) dst[n][k] = *(const PG8_LAS bf16x8*)(lds + PG8_SB(b, h) + boff + n * 2048 + k * 1024); } while (0)
#define PG8_MMA(ai, bj, At, Bt) do { __builtin_amdgcn_s_setprio(1); _Pragma("unroll") for (int m = 0; m < 4; ++m) _Pragma("unroll") for (int n = 0; n < 2; ++n) _Pragma("unroll") for (int k = 0; k < 2; ++k) \
        acc[ai][bj][m][n] = __builtin_amdgcn_mfma_f32_16x16x32_bf16(Bt[n][k], At[m][k], acc[ai][bj][m][n], 0, 0, 0); __builtin_amdgcn_s_setprio(0); } while (0)
#define PG8_WAIT_V(n) asm volatile("s_waitcnt vmcnt(" #n ")" ::: "memory")
#define PG8_WAIT_L(n) asm volatile("s_waitcnt lgkmcnt(" #n ")" ::: "memory")
#define PG8_BAR __builtin_amdgcn_s_barrier()
#define PG8_SCHED __builtin_amdgcn_sched_barrier(0)
    Unit cur, nxt; int ui = 0;
    if (!S.next(0, cur)) return;
    f32x4 acc[2][2][4][2];
#pragma unroll
    for (int a = 0; a < 2; ++a)
#pragma unroll
        for (int b = 0; b < 2; ++b)
#pragma unroll
            for (int m = 0; m < 4; ++m)
#pragma unroll
                for (int n = 0; n < 2; ++n) acc[a][b][m][n] = (f32x4){0.f, 0.f, 0.f, 0.f};
    bf16x8 At[4][2], B0[2][2], B1[2][2];
    const char* cA = PG8_ABASE(cur.pm); const char* cB = (const char*)g.Bt + (size_t)cur.pn * tstep;
    S.a_ready(cur);
    if constexpr (SP2) {
        PG8_STAGE(PG8_SB(0, 0), cB, voffB); PG8_STAGE(PG8_SB(0, 1), cB + hstep, voffB); PG8_STAGE(PG8_SA(0, 0), cA, voffA); PG8_STAGE(PG8_SA(0, 1), cA + hstepA, voffA);
        if (wr == 1) PG8_BAR;
        PG8_WAIT_V(2); PG8_BAR;
        PG8_STAGE(PG8_SB(1, 0), cB + kstep, voffB); PG8_STAGE(PG8_SA(1, 0), cA + kstep, voffA); PG8_STAGE(PG8_SB(1, 1), cB + hstep + kstep, voffB);
        PG8_WAIT_V(6); PG8_BAR;
    } else {
        PG8_STAGE(PG8_SB(0, 0), cB, voffB); PG8_STAGE(PG8_SA(0, 0), cA, voffA); PG8_STAGE(PG8_SB(0, 1), cB + hstep, voffB); PG8_STAGE(PG8_SA(0, 1), cA + hstepA, voffA);
        if (wr == 1) PG8_BAR;
        PG8_WAIT_V(4); PG8_BAR;
        PG8_STAGE(PG8_SB(1, 0), cB + kstep, voffB); PG8_STAGE(PG8_SA(1, 0), cA + kstep, voffA); PG8_STAGE(PG8_SB(1, 1), cB + hstep + kstep, voffB);
        PG8_WAIT_V(6); PG8_BAR;
    }
    for (;;) {
        const bool has_next = S.next(ui + 1, nxt);
        const char* nA = has_next ? PG8_ABASE(nxt.pm) : cA; const char* nB = has_next ? (const char*)g.Bt + (size_t)nxt.pn * tstep : cB;
        for (int t = 0; t < nt; t += 2) {
            const bool last = (t == nt - 2);
            const char* a1 = cA + (size_t)(t + 1) * kstep;
            const char* a2 = last ? nA : cA + (size_t)(t + 2) * kstep; const char* b2 = last ? nB : cB + (size_t)(t + 2) * kstep;
            const char* a3 = a2 + kstep; const char* b3 = b2 + kstep;
            if (last && has_next) S.a_ready(nxt);
            if constexpr (SP2) {
            PG8_LDB(B0, 0, 0); PG8_LDB(B1, 0, 1); PG8_SCHED; PG8_LDA(At, 0, 0); PG8_STAGE(PG8_SA(1, 1), a1 + hstepA, voffA);
            PG8_WAIT_V(8); PG8_WAIT_L(0); PG8_BAR; PG8_MMA(0, 0, At, B0); PG8_MMA(0, 1, At, B1); PG8_BAR; PG8_SCHED;
            PG8_LDA(At, 0, 1); PG8_STAGE(PG8_SB(0, 0), b2, voffB); PG8_STAGE(PG8_SB(0, 1), b2 + hstep, voffB); PG8_STAGE(PG8_SA(0, 0), a2, voffA);
            PG8_WAIT_V(8); PG8_WAIT_L(0); PG8_BAR; PG8_MMA(1, 0, At, B0); PG8_MMA(1, 1, At, B1); PG8_BAR; PG8_SCHED;
            PG8_LDB(B0, 1, 0); PG8_LDB(B1, 1, 1); PG8_SCHED; PG8_LDA(At, 1, 0); PG8_STAGE(PG8_SA(0, 1), a2 + hstepA, voffA);
            PG8_WAIT_V(8); PG8_WAIT_L(0); PG8_BAR; PG8_MMA(0, 0, At, B0); PG8_MMA(0, 1, At, B1); PG8_BAR; PG8_SCHED;
            PG8_LDA(At, 1, 1); PG8_STAGE(PG8_SB(1, 0), b3, voffB); PG8_STAGE(PG8_SB(1, 1), b3 + hstep, voffB); PG8_STAGE(PG8_SA(1, 0), a3, voffA);
            PG8_WAIT_V(8); PG8_WAIT_L(0); PG8_BAR; PG8_MMA(1, 0, At, B0); PG8_MMA(1, 1, At, B1); PG8_BAR; PG8_SCHED;
            } else {
            PG8_LDB(B0, 0, 0); PG8_SCHED; PG8_LDA(At, 0, 0); PG8_STAGE(PG8_SA(1, 1), a1 + hstepA, voffA);
            PG8_WAIT_L(8); PG8_BAR; PG8_WAIT_L(0); PG8_MMA(0, 0, At, B0); PG8_BAR; PG8_SCHED;
            PG8_LDB(B1, 0, 1); PG8_STAGE(PG8_SB(0, 0), b2, voffB);
            PG8_BAR; PG8_WAIT_L(0); PG8_MMA(0, 1, At, B1); PG8_BAR;
            PG8_LDA(At, 0, 1); PG8_STAGE(PG8_SA(0, 0), a2, voffA);
            PG8_BAR; PG8_WAIT_L(0); PG8_MMA(1, 0, At, B0); PG8_BAR; PG8_SCHED;
            PG8_STAGE(PG8_SB(0, 1), b2 + hstep, voffB);
            PG8_WAIT_V(6); PG8_BAR; PG8_MMA(1, 1, At, B1); PG8_BAR;
            PG8_LDB(B0, 1, 0); PG8_SCHED; PG8_LDA(At, 1, 0); PG8_STAGE(PG8_SA(0, 1), a2 + hstepA, voffA);
            PG8_WAIT_L(8); PG8_BAR; PG8_WAIT_L(0); PG8_MMA(0, 0, At, B0); PG8_BAR; PG8_SCHED;
            PG8_LDB(B1, 1, 1); PG8_STAGE(PG8_SB(1, 0), b3, voffB);
            PG8_BAR; PG8_WAIT_L(0); PG8_MMA(0, 1, At, B1); PG8_BAR;
            PG8_LDA(At, 1, 1); PG8_STAGE(PG8_SA(1, 0), a3, voffA);
            PG8_BAR; PG8_WAIT_L(0); PG8_MMA(1, 0, At, B0); PG8_BAR; PG8_SCHED;
            PG8_STAGE(PG8_SB(1, 1), b3 + hstep, voffB);
            PG8_WAIT_V(6); PG8_BAR; PG8_MMA(1, 1, At, B1); PG8_BAR;
            }
        }
        if constexpr (ALIGN_EPI) { if (wr == 0) PG8_BAR; }
        if constexpr (!Epi::AFTER_DRAIN) { E(acc, cur, wr, wc, fr, fq); S.done(cur); }
        if (!has_next) break;
#pragma unroll
        for (int a = 0; a < 2; ++a)
#pragma unroll
            for (int b = 0; b < 2; ++b)
#pragma unroll
                for (int m = 0; m < 4; ++m)
#pragma unroll
                    for (int n = 0; n < 2; ++n) acc[a][b][m][n] = (f32x4){0.f, 0.f, 0.f, 0.f};
        cur = nxt; cA = nA; cB = nB; ++ui;
        if constexpr (ALIGN_EPI) { if (wr == 1) PG8_BAR; }
    }
    PG8_WAIT_V(0);
    if constexpr (!ALIGN_EPI) { if (wr == 0) PG8_BAR; }
    PG8_BAR;
    if constexpr (Epi::AFTER_DRAIN) { E.fused(acc, cur, wr, wc, fr, fq, lds, wid, lane); S.done(cur); }
#undef PG8_ABASE
#undef PG8_SA
#undef PG8_SB
#undef PG8_STAGE
#undef PG8_LDA
#undef PG8_LDB
#undef PG8_MMA
#undef PG8_WAIT_V
#undef PG8_WAIT_L
#undef PG8_BAR
#undef PG8_SCHED
}
}

constexpr int SEQ = 8192, NBATCH = 4, DM = 1024, MTOK = NBATCH * SEQ, MH = MTOK / 2;
constexpr int QKVD = 1536, DFF = 2816, DFF2 = 5632, DIN = 2048, CONVD = 4096, SSDIN = 6208, SSDINP = 6400;
constexpr float EPSF = 1e-6f;
typedef unsigned short bf16;
typedef pg8::f32x4 f32x4;
typedef pg8::u32x4 u32x4;
typedef unsigned u32x2 __attribute__((ext_vector_type(2)));

constexpr size_t MiB = 1u << 20;
constexpr size_t WS_SS = 500 * MiB;
constexpr size_t WS_BAR = 0;
constexpr size_t WS_SWP = 64 * 1024;
constexpr size_t WS_CWP = 1 * MiB;
constexpr size_t WS_ROPE = 1536 * 1024;
constexpr size_t WS_W = 2 * MiB;
constexpr size_t W_ATT_STRIDE = 5 * MiB, W_ATT_WO = 3 * MiB;
constexpr size_t W_SSD0 = 10 * MiB, W_SSD_STRIDE = 16 * MiB + 512 * 1024, W_SSD_WOUT = 12 * MiB + 512 * 1024;
constexpr size_t W_FFN0 = 43 * MiB, W_FFN_STRIDE = 16 * MiB + 512 * 1024, W_FFN_DOWN = 11 * MiB;
constexpr size_t WS_XB = 112 * MiB;
constexpr size_t WS_R = 176 * MiB;
constexpr size_t R_QKV = WS_R, R_OB = WS_R + 96 * MiB;
constexpr size_t R_ACT = WS_R;
constexpr size_t R_Z = WS_R, R_RAW = WS_R + 64 * MiB, R_CONV = WS_R + 192 * MiB, R_DT = WS_R + 320 * MiB;
constexpr size_t R_YF = R_RAW, R_YB = R_RAW + 64 * MiB;
constexpr size_t WS_END = 502 * MiB;
static_assert(WS_END <= 512 * MiB, "ws map");

enum { K_GEMM = 0, K_ATTN = 1, K_FCONV = 2, K_SCONV = 3, K_MARCH = 4, K_COMB = 5 };
struct Step { int kind, layer, sub, hb; };
constexpr int MAXSTEPS = 96;
constexpr int PROBE = 0;
constexpr int MPROBE = 0;
struct Args { const float* in[21]; float* out; unsigned char* ws; int nsteps; int pad; Step steps[MAXSTEPS]; };

__device__ __forceinline__ int wave_id() { return __builtin_amdgcn_readfirstlane((int)(threadIdx.x >> 6)); }
__device__ __forceinline__ int otid() { int t = threadIdx.x; asm volatile("" : "+v"(t)); return t; }
__device__ __forceinline__ float bflo(unsigned u) { return __uint_as_float(u << 16); }
__device__ __forceinline__ float bfhi(unsigned u) { return __uint_as_float(u & 0xffff0000u); }
typedef float f32x2_t __attribute__((ext_vector_type(2))); typedef __bf16 bf16x2_t __attribute__((ext_vector_type(2)));
__device__ __forceinline__ unsigned pk2(float lo, float hi) { f32x2_t v = {lo, hi}; bf16x2_t b = __builtin_convertvector(v, bf16x2_t); return __builtin_bit_cast(unsigned, b); }
__device__ __forceinline__ float bf1(bf16 v) { return __uint_as_float(((unsigned)v) << 16); }
__device__ __forceinline__ float up1_16(float v) { return __builtin_bit_cast(float, __builtin_amdgcn_update_dpp(__builtin_bit_cast(int, v), __builtin_bit_cast(int, v), 0x111, 0xf, 0xf, false)); }
__device__ __forceinline__ float dn1_16(float v) { return __builtin_bit_cast(float, __builtin_amdgcn_update_dpp(__builtin_bit_cast(int, v), __builtin_bit_cast(int, v), 0x101, 0xf, 0xf, false)); }
__device__ __forceinline__ float siluf(float x) { return x * __builtin_amdgcn_rcpf(1.f + __builtin_amdgcn_exp2f(-1.4426950408889634f * x)); }
__device__ __forceinline__ float wave_sum(float v) {
#pragma unroll
    for (int o = 1; o < 64; o <<= 1) v += __shfl_xor(v, o);
    return v;
}

struct EP { int mode, ld0, c0, ld1, c1, ld2, c2, pad; const float* ss_in; bf16* o0; bf16* o1; float* o2; const float* base; float* out; bf16* xb; float* ss_out; const float* cw; const float* cb; };
#define GAS1 __attribute__((address_space(1)))
struct EpiG {
    static constexpr bool PERM = true, AFTER_DRAIN = false;
    const PG8_LAS EP* ep;
    __device__ __forceinline__ void operator()(const f32x4 (&acc)[2][2][4][2], const pg8::Unit& u, int wr, int wc, int fr_, int fq_) const {
        int fr = fr_, fq = fq_; asm volatile("" : "+v"(fr), "+v"(fq));
        const int row0 = u.pm * 256 + wr * 64 + fr;
        const int colb = u.pn * 256 + wc * 32 + 8 * fq;
        const PG8_LAS EP* ep = this->ep; { unsigned epa = (unsigned)(size_t)ep; asm volatile("" : "+v"(epa)); ep = (const PG8_LAS EP*)(size_t)epa; }
        const int mode = ep->mode;
        if (mode == 0) {
            const GAS1 float* ss_in = (const GAS1 float*)ep->ss_in; GAS1 bf16* o0 = (GAS1 bf16*)ep->o0; GAS1 bf16* o1 = (GAS1 bf16*)ep->o1; GAS1 float* o2 = (GAS1 float*)ep->o2;
            const int ld0 = ep->ld0, c0 = ep->c0, ld1 = ep->ld1, c1 = ep->c1, ld2 = ep->ld2, c2 = ep->c2;
            f32x4 ppa[2][4];
#pragma unroll
            for (int ai = 0; ai < 2; ++ai)
#pragma unroll
                for (int m = 0; m < 4; ++m) ppa[ai][m] = *(const GAS1 f32x4*)(ss_in + (size_t)(row0 + ai * 128 + m * 16) * 4);
#pragma unroll
            for (int ai = 0; ai < 2; ++ai) {
                const f32x4 (&pp)[4] = ppa[ai];
#pragma unroll
                for (int m = 0; m < 4; ++m) {
                    const int row = row0 + ai * 128 + m * 16;
                    const float rs = rsqrtf(((pp[m][0] + pp[m][1]) + (pp[m][2] + pp[m][3])) * (1.0f / 1024.0f) + EPSF);
#pragma unroll
                    for (int bj = 0; bj < 2; ++bj) {
                        const int col = colb + bj * 128;
                        const f32x4 v0 = acc[ai][bj][m][0] * rs, v1 = acc[ai][bj][m][1] * rs;
                        if (col < c1) {
                            u32x4 w; w.x = pk2(v0[0], v0[1]); w.y = pk2(v0[2], v0[3]); w.z = pk2(v1[0], v1[1]); w.w = pk2(v1[2], v1[3]);
                            if (col < c0) *(GAS1 u32x4*)(o0 + (size_t)row * ld0 + col) = w;
                            else *(GAS1 u32x4*)(o1 + (size_t)row * ld1 + (col - c0)) = w;
                        } else if (col < c2) {
                            GAS1 float* p = o2 + (size_t)row * ld2 + (col - c1);
                            *(GAS1 f32x4*)p = v0; *(GAS1 f32x4*)(p + 4) = v1;
                        }
                    }
                }
                asm volatile("" ::: "memory");
            }
        } else if (mode == 4) {
            GAS1 bf16* o0 = (GAS1 bf16*)ep->o0; const int ld0 = ep->ld0;
#pragma unroll
            for (int ai = 0; ai < 2; ++ai)
#pragma unroll
                for (int m = 0; m < 4; ++m) { const int row = row0 + ai * 128 + m * 16;
#pragma unroll
                    for (int bj = 0; bj < 2; ++bj) { const f32x4 v0 = acc[ai][bj][m][0], v1 = acc[ai][bj][m][1];
                        u32x4 w; w.x = pk2(v0[0], v0[1]); w.y = pk2(v0[2], v0[3]); w.z = pk2(v1[0], v1[1]); w.w = pk2(v1[2], v1[3]);
                        *(GAS1 u32x4*)(o0 + (size_t)row * ld0 + colb + bj * 128) = w; } }
        } else if (mode == 2) {
            const GAS1 float* ss_in = (const GAS1 float*)ep->ss_in;
            const f32x4 pv2 = *(const GAS1 f32x4*)((const GAS1 float*)ep->cw + (size_t)((u.pn * 128 + wc * 32) >> 2) * 32 + (16 * fq + fr) * 4);
            const int sb = u.pm / 33, ti = u.pm - sb * 33;
            const int tok0 = 252 * ti - 1 + 126 * wr + 8 * fr;
            const size_t rowb = (size_t)sb * SEQ;
            float rs[8];
#pragma unroll
            for (int kb = 0; kb < 1; ++kb) {
                f32x4 pp[8]; bool okr[8];
#pragma unroll
                for (int kk = 0; kk < 8; ++kk) { const int tok = tok0 + kk; okr[kk] = tok >= 0 && tok < SEQ; const int tokc = okr[kk] ? tok : 0;
                    pp[kk] = *(const GAS1 f32x4*)(ss_in + (rowb + tokc) * 4); }
#pragma unroll
                for (int kk = 0; kk < 8; ++kk) { const float r = rsqrtf(((pp[kk][0] + pp[kk][1]) + (pp[kk][2] + pp[kk][3])) * (1.0f / 1024.0f) + EPSF);
                    float rk = okr[kk] ? r : 0.f; asm volatile("" : "+v"(rk)); rs[kk] = rk; }
            }
            GAS1 bf16* act = (GAS1 bf16*)ep->o0;
            PG8_LAS unsigned char* wl = (PG8_LAS unsigned char*)(size_t)(131072 + 256 + (wr * 4 + wc) * 1536);
            *(PG8_LAS f32x4*)(wl + (16 * fq + fr) * 16) = pv2;
#pragma unroll
            for (int kh = 0; kh < 2; ++kh) {
                unsigned outp[4][4];
#pragma unroll
                for (int q = 0; q < 4; ++q) {
                    const int n = q >> 1, e0 = 2 * (q & 1);
                    asm volatile("" : "+v"(rs[0]), "+v"(rs[1]), "+v"(rs[2]), "+v"(rs[3]), "+v"(rs[4]), "+v"(rs[5]), "+v"(rs[6]), "+v"(rs[7]));
                    typedef float f2 __attribute__((ext_vector_type(2)));
                    const PG8_LAS float* wp = (const PG8_LAS float*)(wl + ((2 * fq + n) * 32 + e0) * 4);
                    const f2 wg0 = *(const PG8_LAS f2*)(wp), wg1 = *(const PG8_LAS f2*)(wp + 4), wg2 = *(const PG8_LAS f2*)(wp + 8), bg = *(const PG8_LAS f2*)(wp + 12);
                    const f2 wv0 = *(const PG8_LAS f2*)(wp + 16), wv1 = *(const PG8_LAS f2*)(wp + 20), wv2 = *(const PG8_LAS f2*)(wp + 24), bv = *(const PG8_LAS f2*)(wp + 28);
#define SX(bj_, k_) ((f2){acc[(k_) >> 2][bj_][(k_) & 3][n][e0], acc[(k_) >> 2][bj_][(k_) & 3][n][e0 + 1]} * rs[k_])
                    f2 gm, gc, gp, vm, vc, vp, gl, vl;
                    if (kh == 0) { const f2 g7 = SX(0, 7), v7 = SX(1, 7);
                        gm[0] = up1_16(g7[0]); gm[1] = up1_16(g7[1]); vm[0] = up1_16(v7[0]); vm[1] = up1_16(v7[1]);
                        gl = SX(0, 4); vl = SX(1, 4); gc = SX(0, 0); vc = SX(1, 0);
                    } else { const f2 g0 = SX(0, 0), v0 = SX(1, 0);
                        gl[0] = dn1_16(g0[0]); gl[1] = dn1_16(g0[1]); vl[0] = dn1_16(v0[0]); vl[1] = dn1_16(v0[1]);
                        gm = SX(0, 3); vm = SX(1, 3); gc = SX(0, 4); vc = SX(1, 4); }
#pragma unroll
                    for (int kk = 0; kk < 4; ++kk) {
                        const int k = 4 * kh + kk;
                        if (kk < 3) { gp = SX(0, (kk < 3 ? k + 1 : k)); vp = SX(1, (kk < 3 ? k + 1 : k)); } else { gp = gl; vp = vl; }
                        const f2 G = bg + wg0 * gm + wg1 * gc + wg2 * gp, V = bv + wv0 * vm + wv1 * vc + wv2 * vp;
                        outp[kk][q] = pk2(siluf(G[0]) * V[0], siluf(G[1]) * V[1]);
                        gm = gc; gc = gp; vm = vc; vc = vp;
                    }
#undef SX
                    asm volatile("" : "+v"(outp[0][q]), "+v"(outp[1][q]), "+v"(outp[2][q]), "+v"(outp[3][q]) :: "memory");
                }
#pragma unroll
                for (int kk = 0; kk < 4; ++kk) { int kx = 4 * kh + kk; asm volatile("" : "+v"(kx));
                    const int sidx = 8 * fr + kx, tok = tok0 + kx;
                    if (sidx >= 1 && sidx <= 126 && tok < SEQ) { u32x4 w; w.x = outp[kk][0]; w.y = outp[kk][1]; w.z = outp[kk][2]; w.w = outp[kk][3];
                        *(GAS1 u32x4*)(act + (rowb + tok) * DFF + u.pn * 128 + wc * 32 + 8 * fq) = w; } }
                asm volatile("" ::: "memory");
            }
        } else if (mode == 3) {
            const GAS1 float* ss_in = (const GAS1 float*)ep->ss_in;
            f32x4 pv3a = {0.f, 0.f, 0.f, 0.f}, pv3b = {0.f, 0.f, 0.f, 0.f};
            if (u.pn >= 8 && u.pn < 24 && 16 * fq + fr < 48) { const GAS1 float* src = (const GAS1 float*)ep->cw + (size_t)((u.pn * 256 + wc * 32 - DIN) >> 2) * 24 + (16 * fq + fr) * 4; pv3a = *(const GAS1 f32x4*)src; pv3b = *(const GAS1 f32x4*)(src + 768); }
            const int sb = u.pm / 34, ti = u.pm - sb * 34;
            const int tok0 = 248 * ti - 2 + 124 * wr + 8 * fr;
            const size_t rowb = (size_t)sb * SEQ;
            float rs[8];
#pragma unroll
            for (int kb = 0; kb < 1; ++kb) {
                f32x4 pp[8]; bool okr[8];
#pragma unroll
                for (int kk = 0; kk < 8; ++kk) { const int tok = tok0 + kk; okr[kk] = tok >= 0 && tok < SEQ; const int tokc = okr[kk] ? tok : 0;
                    pp[kk] = *(const GAS1 f32x4*)(ss_in + (rowb + tokc) * 4); }
#pragma unroll
                for (int kk = 0; kk < 8; ++kk) { const float r = rsqrtf(((pp[kk][0] + pp[kk][1]) + (pp[kk][2] + pp[kk][3])) * (1.0f / 1024.0f) + EPSF);
                    float rk = okr[kk] ? r : 0.f; asm volatile("" : "+v"(rk)); rs[kk] = rk; }
            }
            if (u.pn < 8) {
                GAS1 bf16* zo = (GAS1 bf16*)ep->o0;
#pragma unroll
                for (int k = 0; k < 8; ++k) { int kx = k; asm volatile("" : "+v"(kx)); const int sidx = 8 * fr + kx, tok = tok0 + kx;
                    if (sidx >= 2 && sidx <= 125 && tok < SEQ) {
#pragma unroll
                        for (int bj = 0; bj < 2; ++bj) { const f32x4 v0 = acc[k >> 2][bj][k & 3][0] * rs[k], v1 = acc[k >> 2][bj][k & 3][1] * rs[k];
                            u32x4 w; w.x = pk2(v0[0], v0[1]); w.y = pk2(v0[2], v0[3]); w.z = pk2(v1[0], v1[1]); w.w = pk2(v1[2], v1[3]);
                            *(GAS1 u32x4*)(zo + (rowb + tok) * DIN + colb + bj * 128) = w; } } }
            } else if (u.pn == 24) {
                if (wc < 2) { GAS1 float* dto = (GAS1 float*)ep->o2; const GAS1 float* dtb = (const GAS1 float*)ep->cb; const int c0 = wc * 32 + 8 * fq;
                    const f32x4 b0 = *(const GAS1 f32x4*)(dtb + c0), b1 = *(const GAS1 f32x4*)(dtb + c0 + 4);
#pragma unroll
                    for (int k = 0; k < 8; ++k) { int kx = k; asm volatile("" : "+v"(kx)); const int sidx = 8 * fr + kx, tok = tok0 + kx;
                        if (sidx >= 2 && sidx <= 125 && tok < SEQ) { f32x4 v0 = acc[k >> 2][0][k & 3][0] * rs[k] + b0, v1 = acc[k >> 2][0][k & 3][1] * rs[k] + b1;
#pragma unroll
                            for (int e = 0; e < 4; ++e) { v0[e] = fmaxf(v0[e], 0.f) + __logf(1.f + __expf(-fabsf(v0[e]))); v1[e] = fmaxf(v1[e], 0.f) + __logf(1.f + __expf(-fabsf(v1[e]))); }
                            GAS1 float* p = dto + (rowb + tok) * 64 + c0; *(GAS1 f32x4*)p = v0; *(GAS1 f32x4*)(p + 4) = v1; } } }
            } else {
                GAS1 bf16* co = (GAS1 bf16*)ep->o1;
                const int cc0 = colb - DIN;
                unsigned sbase[2]; const unsigned sstride = (cc0 < 2048) ? 32u : 256u;
#pragma unroll
                for (int bj = 0; bj < 2; ++bj) { const unsigned cc = (unsigned)(cc0 + bj * 128);
                    sbase[bj] = (cc < 2048u) ? ((cc >> 5) * (unsigned)(MH * 32) + (cc & 31u)) : (2048u * MH + (((cc - 2048u) & 1023u) >> 7) * (unsigned)(MH * 256) + ((cc >= 3072u) ? 128u : 0u) + (cc & 127u)); }
                PG8_LAS unsigned char* wl = (PG8_LAS unsigned char*)(size_t)(131072 + 256 + (wr * 4 + wc) * 1536);
                { const int ln = 16 * fq + fr; if (ln < 48) { *(PG8_LAS f32x4*)(wl + ln * 16) = pv3a; *(PG8_LAS f32x4*)(wl + 768 + ln * 16) = pv3b; } }
#pragma unroll
                for (int kh = 0; kh < 2; ++kh) {
#pragma unroll
                  for (int bj = 0; bj < 2; ++bj) {
                    unsigned outp[4][4];
#pragma unroll
                    for (int q = 0; q < 4; ++q) {
                        const int n = q >> 1, e0 = 2 * (q & 1);
                        asm volatile("" : "+v"(rs[0]), "+v"(rs[1]), "+v"(rs[2]), "+v"(rs[3]), "+v"(rs[4]), "+v"(rs[5]), "+v"(rs[6]), "+v"(rs[7]));
                        typedef float f2 __attribute__((ext_vector_type(2)));
                        const PG8_LAS float* wp = (const PG8_LAS float*)(wl + bj * 768 + ((2 * fq + n) * 24 + e0) * 4);
                        const f2 w0 = *(const PG8_LAS f2*)(wp), w1 = *(const PG8_LAS f2*)(wp + 4), w2 = *(const PG8_LAS f2*)(wp + 8), w3 = *(const PG8_LAS f2*)(wp + 12), w4 = *(const PG8_LAS f2*)(wp + 16), bb = *(const PG8_LAS f2*)(wp + 20);
#define SX(k_) ((f2){acc[(k_) >> 2][bj][(k_) & 3][n][e0], acc[(k_) >> 2][bj][(k_) & 3][n][e0 + 1]} * rs[k_])
                        f2 ha, hb, hc, hd, he, t1, t2;
                        if (kh == 0) { const f2 s6 = SX(6), s7 = SX(7);
                            ha[0] = up1_16(s6[0]); ha[1] = up1_16(s6[1]); hb[0] = up1_16(s7[0]); hb[1] = up1_16(s7[1]);
                            hc = SX(0); hd = SX(1); he = SX(2); t1 = SX(4); t2 = SX(5);
                        } else { const f2 s0 = SX(0), s1 = SX(1);
                            t1[0] = dn1_16(s0[0]); t1[1] = dn1_16(s0[1]); t2[0] = dn1_16(s1[0]); t2[1] = dn1_16(s1[1]);
                            ha = SX(2); hb = SX(3); hc = SX(4); hd = SX(5); he = SX(6); }
#pragma unroll
                        for (int kk = 0; kk < 4; ++kk) {
                            const f2 v = bb + w0 * ha + w1 * hb + w2 * hc + w3 * hd + w4 * he;
                            outp[kk][q] = pk2(siluf(v[0]), siluf(v[1]));
                            ha = hb; hb = hc; hc = hd; hd = he;
                            he = (kk == 0) ? SX((kh == 0) ? 3 : 7) : (kk == 1) ? t1 : t2;
                        }
#undef SX
                        asm volatile("" : "+v"(outp[0][q]), "+v"(outp[1][q]), "+v"(outp[2][q]), "+v"(outp[3][q]) :: "memory");
                    }
#pragma unroll
                    for (int kk = 0; kk < 4; ++kk) { int kx = 4 * kh + kk; asm volatile("" : "+v"(kx));
                        const int sidx = 8 * fr + kx, tok = tok0 + kx;
                        if (sidx >= 2 && sidx <= 125 && tok < SEQ) {
                            u32x4 wa; wa.x = outp[kk][0]; wa.y = outp[kk][1]; wa.z = outp[kk][2]; wa.w = outp[kk][3];
                            *(GAS1 u32x4*)(co + (sbase[bj] + (unsigned)(rowb + tok) * sstride)) = wa; } }
                    asm volatile("" ::: "memory");
                  }
                }
            }
        } else {
            GAS1 float* out = (GAS1 float*)ep->out; GAS1 bf16* xb = (GAS1 bf16*)ep->xb; GAS1 float* ss_out = (GAS1 float*)ep->ss_out;
#pragma unroll
            for (int ai = 0; ai < 2; ++ai) {
                u32x4 bb[4][2];
#pragma unroll
                for (int m = 0; m < 4; ++m)
#pragma unroll
                    for (int bj = 0; bj < 2; ++bj) bb[m][bj] = *(const GAS1 u32x4*)(xb + (size_t)(row0 + ai * 128 + m * 16) * 1024 + colb + bj * 128);
#pragma unroll
                for (int m = 0; m < 4; ++m) {
                    const int row = row0 + ai * 128 + m * 16;
                    float sq = 0.f;
#pragma unroll
                    for (int bj = 0; bj < 2; ++bj) {
                        const size_t off = (size_t)row * 1024 + colb + bj * 128; const u32x4 bw = bb[m][bj];
                        const f32x4 b0 = {bflo(bw.x), bfhi(bw.x), bflo(bw.y), bfhi(bw.y)}, b1 = {bflo(bw.z), bfhi(bw.z), bflo(bw.w), bfhi(bw.w)};
                        const f32x4 v0 = acc[ai][bj][m][0] + b0, v1 = acc[ai][bj][m][1] + b1;
                        if (out) { *(GAS1 f32x4*)(out + off) = v0; *(GAS1 f32x4*)(out + off + 4) = v1; }
                        u32x4 w; w.x = pk2(v0[0], v0[1]); w.y = pk2(v0[2], v0[3]); w.z = pk2(v1[0], v1[1]); w.w = pk2(v1[2], v1[3]);
                        *(GAS1 u32x4*)(xb + off) = w;
                        const f32x4 r0 = {bflo(w.x), bfhi(w.x), bflo(w.y), bfhi(w.y)}, r1 = {bflo(w.z), bfhi(w.z), bflo(w.w), bfhi(w.w)};
                        sq += (r0[0] * r0[0] + r0[1] * r0[1]) + (r0[2] * r0[2] + r0[3] * r0[3]) + (r1[0] * r1[0] + r1[1] * r1[1]) + (r1[2] * r1[2] + r1[3] * r1[3]);
                    }
                    sq += __shfl_xor(sq, 16); sq += __shfl_xor(sq, 32);
                    if (fq == 0) *(PG8_LAS float*)(size_t)(131328 + ((ai * 128 + wr * 64 + m * 16 + fr) * 4 + wc) * 4) = sq;
                }
                asm volatile("" ::: "memory");
            }
            asm volatile("s_waitcnt lgkmcnt(0)\n\ts_barrier" ::: "memory");
            if (fq < 2) { const int rl = (wr * 4 + wc) * 32 + 16 * fq + fr; const f32x4 q = *(const PG8_LAS f32x4*)(size_t)(131328 + rl * 16);
                ss_out[(size_t)(u.pm * 256 + rl) * 4 + u.pn] = (q[0] + q[1]) + (q[2] + q[3]); }
        }
    }
};

__device__ __forceinline__ void p0_transpose_item(const float* W, const float* g, int K, int N, bf16* WT, float* scr, int item, int lane, int permup) {
    const int nblk = N / 32, kb = item / nblk, nb = item % nblk, k0 = 64 * kb, n0 = 32 * nb;
    float wv[32];
#pragma unroll
    for (int i = 0; i < 32; ++i) wv[i] = __builtin_nontemporal_load(&W[(size_t)(k0 + 2 * i + (lane >> 5)) * N + n0 + (lane & 31)]);
#pragma unroll
    for (int i = 0; i < 32; ++i) { const int kk = 2 * i + (lane >> 5); float v = wv[i]; if (g) v *= g[k0 + kk]; scr[kk * 33 + (lane & 31)] = v; }
    asm volatile("s_waitcnt lgkmcnt(0)" ::: "memory");
    const int c = lane & 7;
#pragma unroll
    for (int j = 0; j < 4; ++j) { const int n = (lane >> 3) + 8 * j; const float* s = scr + (8 * c) * 33 + n;
        u32x4 o; o.x = pk2(s[0 * 33], s[1 * 33]); o.y = pk2(s[2 * 33], s[3 * 33]); o.z = pk2(s[4 * 33], s[5 * 33]); o.w = pk2(s[6 * 33], s[7 * 33]);
        int nr = n0 + n; if (permup) { const int hv = nr >= DFF ? 1 : 0, jj = nr - hv * DFF; nr = 256 * (jj >> 7) + 128 * hv + (jj & 127); }
        *(u32x4*)(WT + (size_t)nr * K + k0 + 8 * c) = o; }
    asm volatile("s_waitcnt lgkmcnt(0)" ::: "memory");
}
__device__ __forceinline__ void p0_matrix(const float* W, const float* g, int K, int N, bf16* WT, float* scr, int gw, int NGW, int lane, int permup = 0) {
    const int nitems = (K / 64) * (N / 32);
    for (int it = gw; it < nitems; it += NGW) p0_transpose_item(W, g, K, N, WT, scr, it, lane, permup);
}

__device__ __forceinline__ void phase0(const Args& a, unsigned char* lds) {
    const int tid = otid(), lane = tid & 63, wave = tid >> 6;
    const int gw = blockIdx.x * 8 + wave, NGW = gridDim.x * 8;
    const int gt = blockIdx.x * 512 + tid, NGT = gridDim.x * 512;
    unsigned char* ws = a.ws;
    float* scr = (float*)(lds + wave * 16384);
    { float* rp = (float*)(ws + WS_ROPE);
      for (int i = gt; i < SEQ * 8; i += NGT) { const int pos = i >> 3, k = i & 7;
          const double invf = (k == 0) ? 1.0 : (k == 1) ? 0.19392274474868576 : (k == 2) ? 0.03760603093086393 : (k == 3) ? 0.007292664737217109 : (k == 4) ? 0.001414213562373095 : (k == 5) ? 0.0002742481756762073 : (k == 6) ? 5.318295896944988e-05 : 1.031338537721246e-05;
          const double rev = (double)pos * invf * 0.15915494309189535; const float fr = (float)(rev - rint(rev));
          rp[2 * i] = __builtin_amdgcn_cosf(fr); rp[2 * i + 1] = __builtin_amdgcn_sinf(fr); } }
    { float* cwp = (float*)(ws + WS_CWP);
      for (int i = gt; i < 4 * (DFF / 4) * 32; i += NGT) { const int e = i & 3, pp = (i >> 2) & 7, q = (i >> 5) % (DFF / 4), L = i / ((DFF / 4) * 32);
          const int j = 4 * q + e + ((pp >= 4) ? DFF : 0), p3 = pp & 3;
          cwp[i] = (p3 < 3) ? a.in[18][((size_t)L * 3 + p3) * DFF2 + j] : a.in[19][(size_t)L * DFF2 + j]; } }
    { float* swp = (float*)(ws + WS_SWP);
      for (int i = gt; i < 2 * (CONVD / 4) * 24; i += NGT) { const int L = i / ((CONVD / 4) * 24), r = i - L * ((CONVD / 4) * 24), q = r / 24, pp = (r % 24) >> 2, e = r & 3, c = 4 * q + e;
          swp[i] = (pp < 5) ? a.in[9][((size_t)L * 5 + pp) * CONVD + c] : a.in[10][(size_t)L * CONVD + c]; } }
    { u32x4* gz = (u32x4*)(ws + WS_XB - 2 * DM * 2); for (int i = gt; i < 2 * DM * 2 / 16; i += NGT) gz[i] = (u32x4){0u, 0u, 0u, 0u}; }
    { const float* x = a.in[0]; bf16* xb = (bf16*)(ws + WS_XB); float* ss = (float*)(ws + WS_SS);
      for (int m = gw; m < MTOK; m += NGW) { const f32x4* xr = (const f32x4*)(x + (size_t)m * DM) + lane; float s = 0.f;
          unsigned long long* o8 = (unsigned long long*)(xb + (size_t)m * DM) + lane;
#pragma unroll
          for (int j = 0; j < 4; ++j) { const f32x4 v = __builtin_nontemporal_load(&xr[64 * j]); s += (v.x * v.x + v.y * v.y) + (v.z * v.z + v.w * v.w);
              o8[64 * j] = (unsigned long long)pk2(v.x, v.y) | ((unsigned long long)pk2(v.z, v.w) << 32); }
          s = wave_sum(s); if (lane < 4) ss[(size_t)m * 4 + lane] = (lane == 0) ? s : 0.f; } }
    for (int j = 0; j < 2; ++j) {
        p0_matrix(a.in[2] + (size_t)j * DM * QKVD, a.in[1] + j * DM, DM, QKVD, (bf16*)(ws + WS_W + j * W_ATT_STRIDE), scr, gw, NGW, lane);
        p0_matrix(a.in[6] + (size_t)j * DM * DM, nullptr, DM, DM, (bf16*)(ws + WS_W + j * W_ATT_STRIDE + W_ATT_WO), scr, gw, NGW, lane);
        bf16* win = (bf16*)(ws + WS_W + W_SSD0 + j * W_SSD_STRIDE);
        p0_matrix(a.in[8] + (size_t)j * DM * SSDIN, a.in[7] + j * DM, DM, SSDIN, win, scr, gw, NGW, lane);
        { u32x4* z = (u32x4*)(win + (size_t)SSDIN * DM); const int n16 = (SSDINP - SSDIN) * DM * 2 / 16; for (int i = gt; i < n16; i += NGT) z[i] = (u32x4){0u, 0u, 0u, 0u}; }
        p0_matrix(a.in[15] + (size_t)j * DIN * DM, nullptr, DIN, DM, (bf16*)(ws + WS_W + W_SSD0 + j * W_SSD_STRIDE + W_SSD_WOUT), scr, gw, NGW, lane);
    }
    for (int i = 0; i < 4; ++i) {
        p0_matrix(a.in[17] + (size_t)i * DM * DFF2, a.in[16] + i * DM, DM, DFF2, (bf16*)(ws + WS_W + W_FFN0 + i * W_FFN_STRIDE), scr, gw, NGW, lane, 1);
        p0_matrix(a.in[20] + (size_t)i * DFF * DM, nullptr, DFF, DM, (bf16*)(ws + WS_W + W_FFN0 + i * W_FFN_STRIDE + W_FFN_DOWN), scr, gw, NGW, lane);
    }
}

#define LAS3 __attribute__((address_space(3)))
typedef short v4i16_t __attribute__((ext_vector_type(4)));
typedef float f32x16 __attribute__((ext_vector_type(16)));
typedef pg8::bf16x8 bf16x8;
constexpr int AT_RS = 144, AT_SK = 0, AT_SV = 384 * 144;
__device__ __forceinline__ void attn_phase(unsigned char* lds_g, const bf16* QKV, bf16* OB, const float* qg, const float* kg, const float* sink, const float* rope) {
    LAS3 unsigned char* lds = (LAS3 unsigned char*)lds_g;
    const int tid = otid(), lane = tid & 63, wave = __builtin_amdgcn_readfirstlane(tid >> 6);
    const int hi = lane >> 5, l32 = lane & 31, blk = (lane >> 4) & 1, q4 = (lane & 15) >> 2, p4 = lane & 3;
    constexpr float LOG2E = 1.4426950408889634f;
    for (int u = blockIdx.x; u < 1024; u += gridDim.x) {
        const int kvh = u & 3, n = (u >> 2) & 63, b = u >> 8;
        __syncthreads();
        { const int sub = tid & 7, r = tid >> 3;
          float kgv[8];
#pragma unroll
          for (int i = 0; i < 8; ++i) kgv[i] = kg[sub * 8 + i];
          u32x4 krs[6], vrs[6];
#pragma unroll
          for (int pass = 0; pass < 6; ++pass) { const int kpos = n * 128 - 128 + pass * 64 + r; const int kc = kpos < 0 ? 0 : (kpos >= SEQ ? SEQ - 1 : kpos);
              const size_t grow = (size_t)b * SEQ + kc;
              krs[pass] = *(const u32x4*)(QKV + grow * QKVD + 1024 + kvh * 64 + sub * 8);
              vrs[pass] = *(const u32x4*)(QKV + grow * QKVD + 1280 + kvh * 64 + sub * 8); }
#pragma unroll
          for (int pass = 0; pass < 6; ++pass) {
              const int jrow = pass * 64 + r, kpos = n * 128 - 128 + jrow;
              if (kpos >= 0 && kpos < SEQ) {
                  const u32x4 kr = krs[pass], vr = vrs[pass];
                  float k[8]; k[0] = bflo(kr.x); k[1] = bfhi(kr.x); k[2] = bflo(kr.y); k[3] = bfhi(kr.y); k[4] = bflo(kr.z); k[5] = bfhi(kr.z); k[6] = bflo(kr.w); k[7] = bfhi(kr.w);
                  float ss = 0.f;
#pragma unroll
                  for (int i = 0; i < 8; ++i) ss += k[i] * k[i];
                  ss += __shfl_xor(ss, 1); ss += __shfl_xor(ss, 2); ss += __shfl_xor(ss, 4);
                  const float rs = rsqrtf(ss * (1.0f / 64.0f) + EPSF);
#pragma unroll
                  for (int i = 0; i < 8; ++i) k[i] = k[i] * rs * kgv[i];
                  if (sub < 2) {
                      const float* rp = rope + (size_t)kpos * 16;
#pragma unroll
                      for (int i = 0; i < 8; ++i) { const float oth = __shfl_xor(k[i], 1); const float c = rp[2 * i], sn = rp[2 * i + 1];
                          k[i] = (sub == 0) ? (k[i] * c - oth * sn) : (k[i] * c + oth * sn); } }
                  u32x4 w; w.x = pk2(k[0], k[1]); w.y = pk2(k[2], k[3]); w.z = pk2(k[4], k[5]); w.w = pk2(k[6], k[7]);
                  *(LAS3 u32x4*)(lds + AT_SK + jrow * AT_RS + sub * 16) = w;
                  *(LAS3 u32x4*)(lds + AT_SV + jrow * AT_RS + sub * 16) = vr;
              }
          }
        }
        const int g = wave >> 1, head = kvh * 4 + g, i0 = 64 * (wave & 1);
        bf16x8 qf[2][4];
#pragma unroll
        for (int t = 0; t < 2; ++t) {
            const int qpos = n * 128 + i0 + 32 * t + l32; const size_t qrow = (size_t)b * SEQ + qpos;
            float qv[4][8]; float ss = 0.f;
#pragma unroll
            for (int ds = 0; ds < 4; ++ds) { const u32x4 w = *(const u32x4*)(QKV + qrow * QKVD + head * 64 + 16 * ds + 8 * hi);
                qv[ds][0] = bflo(w.x); qv[ds][1] = bfhi(w.x); qv[ds][2] = bflo(w.y); qv[ds][3] = bfhi(w.y); qv[ds][4] = bflo(w.z); qv[ds][5] = bfhi(w.z); qv[ds][6] = bflo(w.w); qv[ds][7] = bfhi(w.w);
#pragma unroll
                for (int jj = 0; jj < 8; ++jj) ss += qv[ds][jj] * qv[ds][jj]; }
            ss += __shfl_xor(ss, 32);
            const float rs = rsqrtf(ss * (1.0f / 64.0f) + EPSF);
#pragma unroll
            for (int ds = 0; ds < 4; ++ds)
#pragma unroll
                for (int jj = 0; jj < 8; ++jj) qv[ds][jj] = qv[ds][jj] * rs * qg[16 * ds + 8 * hi + jj];
            const float* rp = rope + (size_t)qpos * 16;
#pragma unroll
            for (int jj = 0; jj < 8; ++jj) { const float oth = __shfl_xor(qv[0][jj], 32); const float c = rp[2 * jj], sn = rp[2 * jj + 1];
                qv[0][jj] = hi ? (qv[0][jj] * c + oth * sn) : (qv[0][jj] * c - oth * sn); }
#pragma unroll
            for (int ds = 0; ds < 4; ++ds) { u32x4 w; const float sc = 0.125f * LOG2E;
                w.x = pk2(qv[ds][0] * sc, qv[ds][1] * sc); w.y = pk2(qv[ds][2] * sc, qv[ds][3] * sc); w.z = pk2(qv[ds][4] * sc, qv[ds][5] * sc); w.w = pk2(qv[ds][6] * sc, qv[ds][7] * sc);
                qf[t][ds] = __builtin_bit_cast(bf16x8, w); }
        }
        const float sink2 = sink[head] * LOG2E;
        float mrun[2] = {sink2, sink2}, lrun[2] = {hi ? 0.f : 1.f, hi ? 0.f : 1.f};
        f32x16 O[2][2];
#pragma unroll
        for (int t = 0; t < 2; ++t)
#pragma unroll
            for (int dt = 0; dt < 2; ++dt)
#pragma unroll
                for (int i = 0; i < 16; ++i) O[t][dt][i] = 0.f;
        __syncthreads();
        const int jlo = (n == 0) ? 128 : 0, jhi = (n == 63) ? 256 : 384;
        for (int jt = 0; jt < 10; ++jt) {
            const int jk = i0 + 32 * jt;
            if (jk < jlo || jk >= jhi) continue;
            bf16x8 kf[4], vf[2][2];
#pragma unroll
            for (int ds = 0; ds < 4; ++ds) kf[ds] = *(const LAS3 bf16x8*)(lds + AT_SK + (jk + l32) * AT_RS + (16 * ds + 8 * hi) * 2);
#pragma unroll
            for (int dt = 0; dt < 2; ++dt)
#pragma unroll
                for (int ks = 0; ks < 2; ++ks) {
                    const int off0 = (jk + 16 * ks + 4 * hi + q4) * AT_RS + (32 * dt + 16 * blk + 4 * p4) * 2;
                    const v4i16_t lo = __builtin_amdgcn_ds_read_tr16_b64_v4i16((LAS3 v4i16_t*)(lds + AT_SV + off0));
                    const v4i16_t hh = __builtin_amdgcn_ds_read_tr16_b64_v4i16((LAS3 v4i16_t*)(lds + AT_SV + off0 + 8 * AT_RS));
                    vf[dt][ks] = (bf16x8){lo[0], lo[1], lo[2], lo[3], hh[0], hh[1], hh[2], hh[3]};
                }
#pragma unroll
            for (int t = 0; t < 2; ++t) {
                if (jt < t || jt >= 9 + t) continue;
                f32x16 S;
#pragma unroll
                for (int i = 0; i < 16; ++i) S[i] = 0.f;
#pragma unroll
                for (int ds = 0; ds < 4; ++ds) S = __builtin_amdgcn_mfma_f32_32x32x16_bf16(kf[ds], qf[t][ds], S, 0, 0, 0);
                if (jt == t) {
#pragma unroll
                    for (int r = 0; r < 16; ++r) { const int kvrel = (r & 3) + 8 * (r >> 2) + 4 * hi; if (kvrel < l32) S[r] = -1e30f; }
                } else if (jt == t + 8) {
#pragma unroll
                    for (int r = 0; r < 16; ++r) { const int kvrel = (r & 3) + 8 * (r >> 2) + 4 * hi; if (kvrel > l32) S[r] = -1e30f; }
                }
                float tmax = S[0];
#pragma unroll
                for (int r = 1; r < 16; ++r) tmax = fmaxf(tmax, S[r]);
                tmax = fmaxf(tmax, __shfl_xor(tmax, 32));
                if (__any(tmax > mrun[t])) {
                    const float mnew = fmaxf(mrun[t], tmax), corr = __builtin_amdgcn_exp2f(mrun[t] - mnew);
                    lrun[t] *= corr; mrun[t] = mnew;
#pragma unroll
                    for (int dt = 0; dt < 2; ++dt)
#pragma unroll
                        for (int i = 0; i < 16; ++i) O[t][dt][i] *= corr;
                }
                float ps = 0.f;
#pragma unroll
                for (int r = 0; r < 16; ++r) { S[r] = __builtin_amdgcn_exp2f(S[r] - mrun[t]); ps += S[r]; }
                lrun[t] += ps;
#pragma unroll
                for (int ks = 0; ks < 2; ++ks) {
                    u32x4 w; w.x = pk2(S[8 * ks], S[8 * ks + 1]); w.y = pk2(S[8 * ks + 2], S[8 * ks + 3]); w.z = pk2(S[8 * ks + 4], S[8 * ks + 5]); w.w = pk2(S[8 * ks + 6], S[8 * ks + 7]);
                    const bf16x8 pb = __builtin_bit_cast(bf16x8, w);
#pragma unroll
                    for (int dt = 0; dt < 2; ++dt) O[t][dt] = __builtin_amdgcn_mfma_f32_32x32x16_bf16(vf[dt][ks], pb, O[t][dt], 0, 0, 0);
                }
            }
        }
#pragma unroll
        for (int t = 0; t < 2; ++t) {
            const float ltot = lrun[t] + __shfl_xor(lrun[t], 32), il = 1.f / ltot;
            const size_t qrow = (size_t)b * SEQ + n * 128 + i0 + 32 * t + l32;
#pragma unroll
            for (int dt = 0; dt < 2; ++dt)
#pragma unroll
                for (int i4 = 0; i4 < 4; ++i4) { u32x2 w; w.x = pk2(O[t][dt][4 * i4] * il, O[t][dt][4 * i4 + 1] * il); w.y = pk2(O[t][dt][4 * i4 + 2] * il, O[t][dt][4 * i4 + 3] * il);
                    *(u32x2*)(OB + qrow * DM + head * 64 + 32 * dt + 8 * i4 + 4 * hi) = w; }
        }
    }
}

__device__ __forceinline__ void ld8(const bf16* p, float (&v)[8]) { const u32x4 w = *(const u32x4*)p; v[0] = bflo(w.x); v[1] = bfhi(w.x); v[2] = bflo(w.y); v[3] = bfhi(w.y); v[4] = bflo(w.z); v[5] = bfhi(w.z); v[6] = bflo(w.w); v[7] = bfhi(w.w); }
__device__ __forceinline__ void ldf8(const float* p, float (&v)[8]) { const f32x4 a = *(const f32x4*)p, b = *(const f32x4*)(p + 4); v[0] = a.x; v[1] = a.y; v[2] = a.z; v[3] = a.w; v[4] = b.x; v[5] = b.y; v[6] = b.z; v[7] = b.w; }
__device__ __forceinline__ void st8(bf16* p, const float (&v)[8]) { u32x4 w; w.x = pk2(v[0], v[1]); w.y = pk2(v[2], v[3]); w.z = pk2(v[4], v[5]); w.w = pk2(v[6], v[7]); *(u32x4*)p = w; }

__device__ __forceinline__ void fconv_phase(const bf16* H, bf16* ACT, const float* cw, const float* cb) {
    const int gt = blockIdx.x * 512 + otid(), NGT = gridDim.x * 512;
    constexpr int NCG = DFF / 8, NITEMS = (MH / 8) * NCG;
    for (int it = gt; it < NITEMS; it += NGT) {
        const int cgx = it % NCG, run = it / NCG, r0 = run * 8, t0 = r0 & (SEQ - 1), j0 = cgx * 8;
        float wg[3][8], wv[3][8], bg[8], bv[8];
#pragma unroll
        for (int k = 0; k < 3; ++k) { ldf8(cw + k * DFF2 + j0, wg[k]); ldf8(cw + k * DFF2 + DFF + j0, wv[k]); }
        ldf8(cb + j0, bg); ldf8(cb + DFF + j0, bv);
        float gm[8], g0[8], gp[8], vm[8], v0[8], vp[8];
        const bf16* hp = H + (size_t)r0 * DFF2 + j0;
        if (t0 > 0) { ld8(hp - DFF2, gm); ld8(hp - DFF2 + DFF, vm); } else {
#pragma unroll
            for (int c = 0; c < 8; ++c) { gm[c] = 0.f; vm[c] = 0.f; } }
        ld8(hp, g0); ld8(hp + DFF, v0);
#pragma unroll
        for (int i = 0; i < 8; ++i) {
            if (i < 7 || t0 + 8 < SEQ) { ld8(hp + (size_t)(i + 1) * DFF2, gp); ld8(hp + (size_t)(i + 1) * DFF2 + DFF, vp); } else {
#pragma unroll
                for (int c = 0; c < 8; ++c) { gp[c] = 0.f; vp[c] = 0.f; } }
            float o[8];
#pragma unroll
            for (int c = 0; c < 8; ++c) { const float G = bg[c] + wg[0][c] * gm[c] + wg[1][c] * g0[c] + wg[2][c] * gp[c]; const float V = bv[c] + wv[0][c] * vm[c] + wv[1][c] * v0[c] + wv[2][c] * vp[c]; o[c] = siluf(G) * V; }
            st8(ACT + (size_t)(r0 + i) * DFF + j0, o);
#pragma unroll
            for (int c = 0; c < 8; ++c) { gm[c] = g0[c]; g0[c] = gp[c]; vm[c] = v0[c]; v0[c] = vp[c]; }
        }
    }
}

__device__ __forceinline__ void sconv_phase(const bf16* RAW, bf16* CONV, float* DT, const float* cw, const float* cb, const float* dtb) {
    const int gt = blockIdx.x * 512 + otid(), NGT = gridDim.x * 512;
    constexpr int NCG = CONVD / 8, NITEMS = (MH / 8) * NCG;
    for (int it = gt; it < NITEMS; it += NGT) {
        const int cgx = it % NCG, run = it / NCG, r0 = run * 8, t0 = r0 & (SEQ - 1), j0 = cgx * 8;
        float w[5][8], bb[8];
#pragma unroll
        for (int k = 0; k < 5; ++k) ldf8(cw + k * CONVD + j0, w[k]);
        ldf8(cb + j0, bb);
        float win[5][8];
        const bf16* hp = RAW + (size_t)r0 * CONVD + j0;
#pragma unroll
        for (int k = 0; k < 4; ++k) { const int dt_ = k - 2;
            if (t0 + dt_ >= 0) ld8(hp + (ptrdiff_t)dt_ * CONVD, win[k]); else {
#pragma unroll
                for (int c = 0; c < 8; ++c) win[k][c] = 0.f; } }
#pragma unroll
        for (int i = 0; i < 8; ++i) {
            if (t0 + i + 2 < SEQ) ld8(hp + (size_t)(i + 2) * CONVD, win[4]); else {
#pragma unroll
                for (int c = 0; c < 8; ++c) win[4][c] = 0.f; }
            float o[8];
#pragma unroll
            for (int c = 0; c < 8; ++c) { const float v = bb[c] + w[0][c] * win[0][c] + w[1][c] * win[1][c] + w[2][c] * win[2][c] + w[3][c] * win[3][c] + w[4][c] * win[4][c]; o[c] = siluf(v); }
            st8(CONV + (size_t)(r0 + i) * CONVD + j0, o);
#pragma unroll
            for (int k = 0; k < 4; ++k)
#pragma unroll
                for (int c = 0; c < 8; ++c) win[k][c] = win[k + 1][c];
        }
    }
    for (int i = gt; i < MH * 64; i += NGT) { const float v = DT[i] + dtb[i & 63]; DT[i] = fmaxf(v, 0.f) + __logf(1.f + __expf(-fabsf(v))); }
}

constexpr int M2_RS = 272, M2_RSX = 80;
constexpr int M2_C = 0, M2_B = 34816, M2_M = 69632, M2_XDT = 104448, M2_XDEC = 114688, M2_S0 = 124928, M2_S1 = 133632, M2_E = 142336, M2_DTV = 142848, M2_TOT = 143360;
__device__ __forceinline__ bf16x8 tr_frag(LAS3 unsigned char* base, int off0, int rs) {
    const v4i16_t lo = __builtin_amdgcn_ds_read_tr16_b64_v4i16((LAS3 v4i16_t*)(base + off0));
    const v4i16_t hi = __builtin_amdgcn_ds_read_tr16_b64_v4i16((LAS3 v4i16_t*)(base + off0 + 4 * rs));
    return (bf16x8){lo[0], lo[1], lo[2], lo[3], hi[0], hi[1], hi[2], hi[3]};
}
__device__ __forceinline__ bf16 f2bf_s(float f) { return (bf16)(pk2(f, 0.f) & 0xffffu); }
#define M2_BAR() asm volatile("s_waitcnt lgkmcnt(0)\n\ts_barrier" ::: "memory")
__device__ __forceinline__ void march_scan(LAS3 unsigned char* sb_, const float* DT, size_t rbase, int col, float A, int dir, int lane) {
    LAS3 float* sE = (LAS3 float*)sb_; LAS3 float* sDt = (LAS3 float*)(sb_ + 512); LAS3 float* sTot = (LAS3 float*)(sb_ + 1024);
    const float dt0 = DT[(rbase + 2 * lane) * 64 + col], dt1 = DT[(rbase + 2 * lane + 1) * 64 + col];
    const float a0 = dt0 * A, a1 = dt1 * A, ps = a0 + a1; float inc = ps;
#pragma unroll
    for (int d = 1; d < 64; d <<= 1) { const float t = __shfl_up(inc, d); if (lane >= d) inc += t; }
    const float tot = __shfl(inc, 63);
    float e0 = inc - a1, e1 = inc;
    if (dir) { e0 = tot - e0 + a0; e1 = tot - e1 + a1; }
    constexpr float L2E = 1.4426950408889634f;
    sE[2 * lane] = e0 * L2E; sE[2 * lane + 1] = e1 * L2E; sDt[2 * lane] = dt0; sDt[2 * lane + 1] = dt1;
    if (lane == 0) sTot[0] = tot * L2E;
}
__device__ __forceinline__ void march_phase(unsigned char* lds_g, const bf16* CONV, const float* DT, bf16* YF, bf16* YB, const float* alog) {
    LAS3 unsigned char* lds = (LAS3 unsigned char*)lds_g;
    const int tid = otid(), lane = tid & 63, wave = __builtin_amdgcn_readfirstlane(tid >> 6);
    const int h = lane >> 5, l32 = lane & 31, blk = (lane >> 4) & 1, q4 = (lane & 15) >> 2, p4 = lane & 3;
    constexpr int SCAN_STRIDE = 1040;
    for (int it = blockIdx.x; it < 256; it += gridDim.x) {
        const int xcd = it & 7, slot = it >> 3, set = xcd * 4 + (slot >> 3), mem = slot & 7;
        const int bl = set >> 4, grp = (set >> 1) & 7, dir = set & 1, head = grp * 4 + (mem >> 1), ph = mem & 1;
        const float A = -__expf(alog[dir * 32 + head]);
        bf16* Y = dir ? YB : YF;
        f32x16 Sacc;
#pragma unroll
        for (int i = 0; i < 16; ++i) Sacc[i] = 0.f;
        __syncthreads();
        for (int i = tid; i < 8704 / 16; i += 512) *(LAS3 u32x4*)(lds + M2_S0 + i * 16) = (u32x4){0u, 0u, 0u, 0u};
        u32x4 rc[4], rb[4], rx;
        {   const size_t rbase = (size_t)bl * SEQ + (size_t)(dir ? 63 : 0) * 128;
#pragma unroll
            for (int q = 0; q < 4; ++q) { const int idx = tid + 512 * q, row = idx >> 4, part = idx & 15;
                const bf16* bc = CONV + (size_t)2048 * MH + ((size_t)grp * MH + rbase + row) * 256 + part * 8;
                rb[q] = *(const u32x4*)bc; rc[q] = *(const u32x4*)(bc + 128); }
            rx = *(const u32x4*)(CONV + ((size_t)(head * 2 + ph) * MH + rbase + (tid >> 2)) * 32 + (tid & 3) * 8);
            if (wave == 4) march_scan(lds + M2_E, DT, rbase, dir * 32 + head, A, dir, lane);
        }
        for (int ci = 0; ci < 64; ++ci) {
            const int c = dir ? (63 - ci) : ci;
            const size_t rbase = (size_t)bl * SEQ + (size_t)c * 128;
            LAS3 unsigned char* scb = lds + M2_E + (ci & 1) * SCAN_STRIDE;
            LAS3 float* sE = (LAS3 float*)scb; LAS3 float* sDt = (LAS3 float*)(scb + 512);
            M2_BAR();
#pragma unroll
            for (int q = 0; q < 4; ++q) { const int idx = tid + 512 * q, row = idx >> 4, part = idx & 15;
                *(LAS3 u32x4*)(lds + M2_C + row * M2_RS + part * 16) = rc[q];
                *(LAS3 u32x4*)(lds + M2_B + row * M2_RS + part * 16) = rb[q]; }
            const float tot = *(LAS3 float*)(scb + 1024);
            {   const int row = tid >> 2, part = tid & 3; const float dtv = sDt[row], f2 = dtv * __builtin_amdgcn_exp2f(tot - sE[row]);
                float xv[8]; xv[0] = bflo(rx.x); xv[1] = bfhi(rx.x); xv[2] = bflo(rx.y); xv[3] = bfhi(rx.y); xv[4] = bflo(rx.z); xv[5] = bfhi(rx.z); xv[6] = bflo(rx.w); xv[7] = bfhi(rx.w);
                u32x4 w1, w2;
                w1.x = pk2(xv[0] * dtv, xv[1] * dtv); w1.y = pk2(xv[2] * dtv, xv[3] * dtv); w1.z = pk2(xv[4] * dtv, xv[5] * dtv); w1.w = pk2(xv[6] * dtv, xv[7] * dtv);
                w2.x = pk2(xv[0] * f2, xv[1] * f2); w2.y = pk2(xv[2] * f2, xv[3] * f2); w2.z = pk2(xv[4] * f2, xv[5] * f2); w2.w = pk2(xv[6] * f2, xv[7] * f2);
                *(LAS3 u32x4*)(lds + M2_XDT + row * M2_RSX + part * 16) = w1;
                *(LAS3 u32x4*)(lds + M2_XDEC + row * M2_RSX + part * 16) = w2; }
            M2_BAR();
            const int cn = dir ? (62 - ci) : (ci + 1); const size_t rb2 = (size_t)bl * SEQ + (size_t)cn * 128;
            if (ci + 1 < 64) {
#pragma unroll
                for (int q = 0; q < 4; ++q) { const int idx = tid + 512 * q, row = idx >> 4, part = idx & 15;
                    const bf16* bc = CONV + (size_t)2048 * MH + ((size_t)grp * MH + rb2 + row) * 256 + part * 8;
                    rb[q] = *(const u32x4*)bc; rc[q] = *(const u32x4*)(bc + 128); }
                rx = *(const u32x4*)(CONV + ((size_t)(head * 2 + ph) * MH + rb2 + (tid >> 2)) * 32 + (tid & 3) * 8);
            }
            for (int rep1 = 0; rep1 < (MPROBE == 1 ? 2 : 1); ++rep1)
            {
                const int sh4 = 4 * wave, rbF = (0x02101233 >> sh4) & 15, c0F = (0x02001020 >> sh4) & 15, ntl = (0x01111222 >> sh4) & 15;
                const int rbk = dir ? 3 - rbF : rbF, cb0 = dir ? ((ntl == 2 ? 2 : 3) - c0F) : c0F;
                const bool need0 = ntl >= 1, need1 = ntl >= 2;
                f32x16 g0, g1;
#pragma unroll
                for (int i = 0; i < 16; ++i) { g0[i] = 0.f; g1[i] = 0.f; }
                if (need0 || need1) {
#pragma unroll
                    for (int kk = 0; kk < 8; ++kk) {
                        const bf16x8 av = *(const LAS3 bf16x8*)(lds + M2_C + (32 * rbk + l32) * M2_RS + (16 * kk + 8 * h) * 2);
                        if (need0) { const bf16x8 bv = *(const LAS3 bf16x8*)(lds + M2_B + (32 * cb0 + l32) * M2_RS + (16 * kk + 8 * h) * 2); g0 = __builtin_amdgcn_mfma_f32_32x32x16_bf16(av, bv, g0, 0, 0, 0); }
                        if (need1) { const bf16x8 bv = *(const LAS3 bf16x8*)(lds + M2_B + (32 * (cb0 + 1) + l32) * M2_RS + (16 * kk + 8 * h) * 2); g1 = __builtin_amdgcn_mfma_f32_32x32x16_bf16(av, bv, g1, 0, 0, 0); }
                    }
                }
                int oz = 0; asm volatile("" : "+v"(oz));
                const int s0 = 32 * cb0 + l32 + oz, s1 = s0 + 32;
#pragma unroll
                for (int t = 0; t < 2; ++t) {
                    const bool need = t ? need1 : need0; const int sc = t ? s1 : s0; const bool diag = (cb0 + t) == rbk;
                    LAS3 unsigned char* mrow = lds + M2_M + sc * M2_RS + (32 * rbk + 4 * h) * 2;
                    if (need) {
                        const float Es = sE[sc];
#pragma unroll
                        for (int i4 = 0; i4 < 4; ++i4) {
                            float v[4];
#pragma unroll
                            for (int e = 0; e < 4; ++e) { const int i = 4 * i4 + e, l = 32 * rbk + 8 * i4 + 4 * h + e;
                                const float gg = t ? g1[i] : g0[i]; float x = gg * __builtin_amdgcn_exp2f(sE[l] - Es);
                                if (diag) { const bool ok = dir ? (sc >= l) : (sc <= l); x = ok ? x : 0.f; }
                                v[e] = x; }
                            u32x2 w; w.x = pk2(v[0], v[1]); w.y = pk2(v[2], v[3]);
                            *(LAS3 u32x2*)(mrow + 16 * i4) = w;
                        }
                    }
                }
            }
            M2_BAR();
            LAS3 unsigned char* sScur = lds + ((ci & 1) ? M2_S1 : M2_S0); LAS3 unsigned char* sSnxt = lds + ((ci & 1) ? M2_S0 : M2_S1);
            for (int rep2 = 0; rep2 < (MPROBE == 2 ? 2 : 1); ++rep2)
            if (wave < 4) {
                const int l0 = 32 * wave;
                f32x16 yd, yo;
#pragma unroll
                for (int i = 0; i < 16; ++i) { yd[i] = 0.f; yo[i] = 0.f; }
                const int klo = dir ? 2 * wave : 0, khi = dir ? 8 : 2 * (wave + 1);
#pragma unroll
                for (int kk = 0; kk < 8; ++kk) {
                    if (kk >= klo && kk < khi) {
                        const bf16x8 av = tr_frag(lds + M2_M, (16 * kk + 8 * h + q4) * M2_RS + (l0 + 16 * blk + 4 * p4) * 2, M2_RS);
                        const bf16x8 bv = tr_frag(lds + M2_XDT, (16 * kk + 8 * h + q4) * M2_RSX + (16 * blk + 4 * p4) * 2, M2_RSX);
                        yd = __builtin_amdgcn_mfma_f32_32x32x16_bf16(av, bv, yd, 0, 0, 0); }
                    const bf16x8 av2 = *(const LAS3 bf16x8*)(lds + M2_C + (l0 + l32) * M2_RS + (16 * kk + 8 * h) * 2);
                    const bf16x8 bv2 = *(const LAS3 bf16x8*)(sScur + l32 * M2_RS + (16 * kk + 8 * h) * 2);
                    yo = __builtin_amdgcn_mfma_f32_32x32x16_bf16(av2, bv2, yo, 0, 0, 0);
                }
#pragma unroll
                for (int i = 0; i < 16; ++i) { const int l = l0 + 8 * (i >> 2) + 4 * h + (i & 3);
                    const float y = yd[i] + __builtin_amdgcn_exp2f(sE[l]) * yo[i];
                    Y[(rbase + l) * DIN + head * 64 + ph * 32 + l32] = f2bf_s(y); }
            } else {
                const int n0 = 32 * (wave - 4);
                const float et = __builtin_amdgcn_exp2f(tot);
#pragma unroll
                for (int i = 0; i < 16; ++i) Sacc[i] *= et;
#pragma unroll
                for (int kk = 0; kk < 8; ++kk) {
                    const bf16x8 av = tr_frag(lds + M2_XDEC, (16 * kk + 8 * h + q4) * M2_RSX + (16 * blk + 4 * p4) * 2, M2_RSX);
                    const bf16x8 bv = tr_frag(lds + M2_B, (16 * kk + 8 * h + q4) * M2_RS + (n0 + 16 * blk + 4 * p4) * 2, M2_RS);
                    Sacc = __builtin_amdgcn_mfma_f32_32x32x16_bf16(av, bv, Sacc, 0, 0, 0);
                }
#pragma unroll
                for (int i4 = 0; i4 < 4; ++i4)
#pragma unroll
                    for (int e = 0; e < 4; ++e) { const int p = 8 * i4 + 4 * h + e;
                        *(LAS3 bf16*)(sSnxt + p * M2_RS + (n0 + l32) * 2) = f2bf_s(Sacc[4 * i4 + e]); }
                if (wave == 4 && ci + 1 < 64) march_scan(lds + M2_E + ((ci + 1) & 1) * SCAN_STRIDE, DT, rb2, dir * 32 + head, A, dir, lane);
            }
        }
        asm volatile("s_waitcnt vmcnt(0)" ::: "memory");
    }
}

__device__ __forceinline__ void comb_phase(bf16* Z, const bf16* YF, const bf16* YB, const float* gg, const bf16* CONV, const float* dsk) {
    const int tid = otid(), lane = tid & 63, wave = tid >> 6, l5 = lane & 31, hsel = lane >> 5;
    const int gw = blockIdx.x * 8 + wave, NGW = gridDim.x * 8;
    for (int ip = gw; ip < MH * 4; ip += NGW) {
        const int it = 2 * ip + hsel, g = it & 7, r = it >> 3; const int c0 = g * 256 + 8 * l5; const size_t off = (size_t)r * DIN + c0;
        const u32x4 a = __builtin_nontemporal_load((const u32x4*)(YF + off)), b = __builtin_nontemporal_load((const u32x4*)(YB + off)), z = *(const u32x4*)(Z + off);
        const u32x4 xr = *(const u32x4*)(CONV + ((size_t)(c0 >> 5) * MH + r) * 32 + (c0 & 31)); const float dh = dsk[g * 4 + (l5 >> 3)];
        const f32x4 gv0 = *(const f32x4*)(gg + c0), gv1 = *(const f32x4*)(gg + c0 + 4);
        float y[8];
        y[0] = (bflo(a.x) + bflo(b.x) + dh * bflo(xr.x)) * siluf(bflo(z.x)); y[1] = (bfhi(a.x) + bfhi(b.x) + dh * bfhi(xr.x)) * siluf(bfhi(z.x));
        y[2] = (bflo(a.y) + bflo(b.y) + dh * bflo(xr.y)) * siluf(bflo(z.y)); y[3] = (bfhi(a.y) + bfhi(b.y) + dh * bfhi(xr.y)) * siluf(bfhi(z.y));
        y[4] = (bflo(a.z) + bflo(b.z) + dh * bflo(xr.z)) * siluf(bflo(z.z)); y[5] = (bfhi(a.z) + bfhi(b.z) + dh * bfhi(xr.z)) * siluf(bfhi(z.z));
        y[6] = (bflo(a.w) + bflo(b.w) + dh * bflo(xr.w)) * siluf(bflo(z.w)); y[7] = (bfhi(a.w) + bfhi(b.w) + dh * bfhi(xr.w)) * siluf(bfhi(z.w));
        float ss = ((y[0] * y[0] + y[1] * y[1]) + (y[2] * y[2] + y[3] * y[3])) + ((y[4] * y[4] + y[5] * y[5]) + (y[6] * y[6] + y[7] * y[7]));
#pragma unroll
        for (int o = 1; o < 32; o <<= 1) ss += __shfl_xor(ss, o);
        const float rs = rsqrtf(ss * (1.0f / 256.0f) + EPSF);
        u32x4 w; w.x = pk2(y[0] * rs * gv0.x, y[1] * rs * gv0.y); w.y = pk2(y[2] * rs * gv0.z, y[3] * rs * gv0.w); w.z = pk2(y[4] * rs * gv1.x, y[5] * rs * gv1.y); w.w = pk2(y[6] * rs * gv1.z, y[7] * rs * gv1.w);
        *(u32x4*)(Z + off) = w;
    }
}

#define LAS __attribute__((address_space(3)))
#define XB_TMO      128
#define XB_XCNT(j)  (256  + 64 * (j))
#define XB_XSUB(j)  (1280 + 64 * (j))
#define XB_XGEN(j)  (2304 + 64 * (j))
#define XB_TOP      3328
#define XB_TOPGEN   3392
#define XCD_BAR_WORDS 3456
#define XB_SPIN_CAP (1u << 18)

__device__ __forceinline__ unsigned xb_ld(unsigned* p)              { return __hip_atomic_load(p, __ATOMIC_RELAXED, __HIP_MEMORY_SCOPE_AGENT); }
__device__ __forceinline__ unsigned xb_add(unsigned* p, unsigned v) { return __hip_atomic_fetch_add(p, v, __ATOMIC_RELAXED, __HIP_MEMORY_SCOPE_AGENT); }
__device__ __forceinline__ unsigned xb_xcc_id() { return (unsigned)__builtin_amdgcn_s_getreg((3 << 11) | 20) & 0xFu; }
#define XB_SPIN(cond, bar) do { unsigned _sp = 0; while (cond) { __builtin_amdgcn_s_sleep(1); \
    if ((++_sp & 255u) == 0u) { if (xb_ld(&(bar)[XB_TMO])) break; if (_sp > XB_SPIN_CAP) { atomicAdd(&(bar)[XB_TMO], 1u); break; } } } } while (0)

struct XcdBarrier {
    unsigned* bar; unsigned x;
    volatile LAS unsigned* st;
};

__device__ __forceinline__ XcdBarrier xcd_barrier_post(unsigned* bar, volatile LAS unsigned* st) {
    XcdBarrier b; b.bar = bar; b.x = xb_xcc_id(); b.st = st;
    if (threadIdx.x == 0) (void)xb_add(&bar[XB_XCNT(b.x)], 1u);
    return b;
}
__device__ __forceinline__ void xcd_barrier_complete(unsigned* bar, unsigned x, unsigned& nloc, unsigned& nx) {
    const unsigned G = gridDim.x * gridDim.y * gridDim.z;
    unsigned sum, cnt, mine, sp = 0u;
    for (;;) {
        sum = 0u; cnt = 0u; mine = 0u;
#pragma unroll
        for (unsigned j = 0; j < 16; ++j) { const unsigned c = xb_ld(&bar[XB_XCNT(j)]); sum += c; cnt += (c > 0u) ? 1u : 0u; mine = (j == x) ? c : mine; }
        if (sum == G) break;
        __builtin_amdgcn_s_sleep(1);
        if ((++sp & 255u) == 0u) { if (xb_ld(&bar[XB_TMO])) break; if (sp > XB_SPIN_CAP) { atomicAdd(&bar[XB_TMO], 1u); break; } }
    }
    nloc = mine > 0u ? mine : 1u; nx = cnt > 0u ? cnt : 1u;
}

__device__ __forceinline__ void xcd_barrier(const XcdBarrier& b) {
    asm volatile("s_waitcnt vmcnt(0)" ::: "memory");
    __syncthreads();
    if (threadIdx.x == 0) {
        unsigned* bar = b.bar;
        __builtin_amdgcn_s_waitcnt(0);
        unsigned nloc = b.st[0], nx = b.st[1];
        if (nloc == 0u) { xcd_barrier_complete(bar, b.x, nloc, nx); b.st[0] = nloc; b.st[1] = nx; }
        const unsigned old = xb_add(&bar[XB_XSUB(b.x)], 1u);
        const unsigned gen = old / nloc;
        if (old + 1u == (gen + 1u) * nloc) {
            __builtin_amdgcn_fence(__ATOMIC_RELEASE, "agent");
            asm volatile("s_waitcnt vmcnt(0)" ::: "memory");
            const unsigned og = xb_add(&bar[XB_TOP], 1u);
            const unsigned tg = og / nx;
            if (og + 1u == (tg + 1u) * nx) xb_add(&bar[XB_TOPGEN], 1u);
            else XB_SPIN(xb_ld(&bar[XB_TOPGEN]) == tg, bar);
            __builtin_amdgcn_fence(__ATOMIC_ACQUIRE, "agent");
            xb_add(&bar[XB_XGEN(b.x)], 1u);
            asm volatile("s_waitcnt vmcnt(0)" ::: "memory");
        } else {
            XB_SPIN(xb_ld(&bar[XB_XGEN(b.x)]) == gen, bar);
            __builtin_amdgcn_fence(__ATOMIC_ACQUIRE, "agent");
            asm volatile("s_waitcnt vmcnt(0)" ::: "memory");
        }
    }
    __syncthreads();
}

constexpr int LDS_BYTES = 147456;
__global__ void __launch_bounds__(512, 2) mega_fwd(Args a) {
    __shared__ __attribute__((aligned(16))) unsigned char lds[LDS_BYTES];
    if (a.nsteps < 0) cg::this_grid().sync();
    unsigned char* ws = a.ws;
    volatile LAS unsigned* bst = (volatile LAS unsigned*)((LAS unsigned char*)lds + 147456 - 16);
    if (threadIdx.x < 2) bst[threadIdx.x] = 0u;
    __syncthreads();
    const XcdBarrier gbar = xcd_barrier_post((unsigned*)(ws + WS_BAR), bst);
    phase0(a, lds);
    xcd_barrier(gbar);
    if (PROBE == 8) { phase0(a, lds); xcd_barrier(gbar); }
    float* SS = (float*)(ws + WS_SS);
    bf16* XB = (bf16*)(ws + WS_XB);
    const float* rope = (const float*)(ws + WS_ROPE);
    for (int s = 0; s < a.nsteps; ++s) {
        const Step st = a.steps[s];
        const int L = st.layer, j = L >> 1, hb = st.hb;
        const size_t rowoff = (size_t)hb * MH;
        if (st.kind == K_GEMM) {
            pg8::Gemm g; EP e;
            e.mode = 0; e.ss_in = nullptr; e.o0 = nullptr; e.ld0 = 0; e.c0 = 0; e.o1 = nullptr; e.ld1 = 0; e.c1 = 0; e.o2 = nullptr; e.ld2 = 0; e.c2 = 0; e.pad = 0;
            e.base = nullptr; e.out = nullptr; e.xb = nullptr; e.ss_out = nullptr; e.cw = nullptr; e.cb = nullptr;
            const int sub = st.sub;
            if (sub == 0) {
                g.A = XB; g.Bt = (const bf16*)(ws + WS_W + j * W_ATT_STRIDE); g.M = MTOK; g.N = QKVD; g.K = DM;
                e.ss_in = SS; e.o0 = (bf16*)(ws + R_QKV); e.ld0 = QKVD; e.c0 = QKVD; e.c1 = QKVD; e.c2 = QKVD;
            } else if (sub == 6) {
                g.A = XB; g.Bt = (const bf16*)(ws + WS_W + j * W_ATT_STRIDE); g.M = MTOK; g.N = QKVD; g.K = DM;
                e.mode = 4; e.o0 = (bf16*)(ws + WS_R + 160 * MiB); e.ld0 = QKVD;
            } else if (sub == 1) {
                g.A = (const bf16*)(ws + R_OB); g.Bt = (const bf16*)(ws + WS_W + j * W_ATT_STRIDE + W_ATT_WO); g.M = MTOK; g.N = DM; g.K = DM;
                e.mode = 1; e.out = nullptr; e.xb = XB; e.ss_out = SS;
            } else if (sub == 2) {
                g.A = XB + rowoff * DM; g.Bt = (const bf16*)(ws + WS_W + W_SSD0 + j * W_SSD_STRIDE); g.M = 68 * 256; g.N = SSDINP; g.K = DM;
                e.mode = 3; e.ss_in = SS + rowoff * 4; e.o0 = (bf16*)(ws + R_Z); e.o1 = (bf16*)(ws + R_CONV); e.o2 = (float*)(ws + R_DT);
                e.cw = (const float*)(ws + WS_SWP) + (size_t)j * (CONVD / 4) * 24; e.cb = a.in[11] + j * 64;
            } else if (sub == 3) {
                g.A = (const bf16*)(ws + R_Z); g.Bt = (const bf16*)(ws + WS_W + W_SSD0 + j * W_SSD_STRIDE + W_SSD_WOUT); g.M = MH; g.N = DM; g.K = DIN;
                e.mode = 1; e.out = nullptr; e.xb = XB + rowoff * DM; e.ss_out = SS + rowoff * 4;
            } else if (sub == 4) {
                g.A = XB; g.Bt = (const bf16*)(ws + WS_W + W_FFN0 + L * W_FFN_STRIDE); g.M = 132 * 256; g.N = DFF2; g.K = DM;
                e.mode = 2; e.ss_in = SS; e.o0 = (bf16*)(ws + R_ACT); e.cw = (const float*)(ws + WS_CWP) + (size_t)L * (DFF / 4) * 32; e.cb = nullptr;
            } else {
                g.A = (const bf16*)(ws + R_ACT); g.Bt = (const bf16*)(ws + WS_W + W_FFN0 + L * W_FFN_STRIDE + W_FFN_DOWN); g.M = MTOK; g.N = DM; g.K = DFF;
                e.mode = 1; e.out = (L == 3) ? a.out : nullptr; e.xb = XB; e.ss_out = SS;
            }
            PG8_LAS EP* epl = (PG8_LAS EP*)((PG8_LAS unsigned char*)lds + 131072);
            if (otid() == 0) { epl->mode = e.mode; epl->ld0 = e.ld0; epl->c0 = e.c0; epl->ld1 = e.ld1; epl->c1 = e.c1; epl->ld2 = e.ld2; epl->c2 = e.c2; epl->pad = 0;
                epl->ss_in = e.ss_in; epl->o0 = e.o0; epl->o1 = e.o1; epl->o2 = e.o2; epl->base = e.base; epl->out = e.out; epl->xb = e.xb; epl->ss_out = e.ss_out; epl->cw = e.cw; epl->cb = e.cb; }
            __syncthreads();
            EpiG E; E.ep = epl;
            pg8::StaticOrder S; S.init(g.M, g.N, (int)gridDim.x, (int)blockIdx.x);
            g.amode = (sub == 4) ? 1 : (sub == 2) ? 2 : 0;
            pg8::gemm_phase<EpiG, pg8::StaticOrder, true, true>((PG8_LAS unsigned char*)lds, g, S, E);
        } else if (st.kind == K_ATTN) {
            attn_phase(lds, (const bf16*)(ws + R_QKV), (bf16*)(ws + R_OB), a.in[3] + j * 64, a.in[4] + j * 64, a.in[5] + j * 16, rope);
        } else if (st.kind == K_FCONV) {
            ;
        } else if (st.kind == K_SCONV) {
            sconv_phase((const bf16*)(ws + R_RAW), (bf16*)(ws + R_CONV), (float*)(ws + R_DT), a.in[9] + (size_t)j * 5 * CONVD, a.in[10] + (size_t)j * CONVD, a.in[11] + j * 64);
        } else if (st.kind == K_MARCH) {
            march_phase(lds, (const bf16*)(ws + R_CONV), (const float*)(ws + R_DT), (bf16*)(ws + R_YF), (bf16*)(ws + R_YB), a.in[12] + j * 64);
        } else if (st.kind == K_COMB) {
            comb_phase((bf16*)(ws + R_Z), (const bf16*)(ws + R_YF), (const bf16*)(ws + R_YB), a.in[14] + (size_t)j * DIN, (const bf16*)(ws + R_CONV), a.in[13] + j * 32);
        }
        xcd_barrier(gbar);
    }
}

extern "C" void kernel_launch(void* const* d_in, const int* in_sizes, int n_in, void* d_out, int out_size, void* d_ws, size_t ws_size, hipStream_t stream) {
    static int grid = 0;
    if (grid == 0) {
        if (n_in != 21 || out_size != MTOK * DM || ws_size < WS_END) { fprintf(stderr, "kernel_launch: unexpected shapes (n_in %d out %d ws %zu)\n", n_in, out_size, ws_size); grid = -1; return; }
        int dev = 0, cus = 0, per_cu = 0;
        hipGetDevice(&dev); hipDeviceGetAttribute(&cus, hipDeviceAttributeMultiprocessorCount, dev);
        hipOccupancyMaxActiveBlocksPerMultiprocessor(&per_cu, (const void*)mega_fwd, 512, 0);
        if (per_cu < 1) per_cu = 1;
        grid = cus;
    }
    if (grid < 0) return;
    Args a{};
    for (int i = 0; i < 21; ++i) a.in[i] = (const float*)d_in[i];
    a.out = (float*)d_out; a.ws = (unsigned char*)d_ws;
    int n = 0;
    auto add = [&](int kind, int layer, int sub, int hb) { a.steps[n].kind = kind; a.steps[n].layer = layer; a.steps[n].sub = sub; a.steps[n].hb = hb; ++n; };
    for (int L = 0; L < 4; ++L) {
        if ((L & 1) == 0) { add(K_GEMM, L, 0, 0); if (PROBE == 5) add(K_GEMM, L, 0, 0); if (PROBE == 7) add(K_GEMM, L, 6, 0); add(K_ATTN, L, 0, 0); if (PROBE == 3) add(K_ATTN, L, 0, 0); add(K_GEMM, L, 1, 0); }
        else for (int hb = 0; hb < 2; ++hb) { add(K_GEMM, L, 2, hb); if (PROBE == 4) add(K_GEMM, L, 2, hb); add(K_MARCH, L, 0, hb); if (PROBE == 2) add(K_MARCH, L, 0, hb); add(K_COMB, L, 0, hb); add(K_GEMM, L, 3, hb); }
        add(K_GEMM, L, 4, 0); if (PROBE == 1) add(K_GEMM, L, 4, 0); add(K_GEMM, L, 5, 0);
        if (PROBE == 6) for (int r = 0; r < 8; ++r) add(99, L, 0, 0);
    }
    a.nsteps = n;
    if (hipMemsetAsync(d_ws, 0, 16384, stream) != hipSuccess) { fprintf(stderr, "memset of the barrier words failed\n"); return; }
    void* args[] = {&a};
    hipError_t e = hipLaunchCooperativeKernel((const void*)mega_fwd, dim3(grid), dim3(512), args, 0, stream);
    if (e != hipSuccess) fprintf(stderr, "cooperative launch failed: %s (grid %d)\n", hipGetErrorString(e), grid);
}
```

```cpp
#include <hip/hip_runtime.h>
#include <hip/hip_cooperative_groups.h>
#include <cstdio>
#include <cstdint>
namespace cg = cooperative_groups;
namespace pg8 {
#define PG8_LAS __attribute__((address_space(3)))
typedef unsigned short bf16_t;
typedef short bf16x8 __attribute__((ext_vector_type(8)));
typedef float f32x4 __attribute__((ext_vector_type(4)));
typedef unsigned u32x4 __attribute__((ext_vector_type(4)));
constexpr int BM = 256, BK = 64, HALF = 128, HTB = HALF * BK * 2  , STAGE_BYTES = 8 * HTB, NXCD = 8, WGM = 4;

__host__ __device__ __forceinline__ int lds_byte(int r, int c) { const int st = (r >> 4) * 2 + (c >> 5), rr = r & 15, cc = c & 31, ob = rr * 64 + cc * 2; return st * 1024 + (ob ^ (((ob >> 9) & 1) << 5)); }
__host__ __device__ __forceinline__ void stage_rc(int b, int& R, int& C) { const int st = b / 1024, sb = b % 1024, swz = sb ^ (((sb >> 9) & 1) << 5); R = (st >> 1) * 16 + swz / 64; C = (st & 1) * 32 + (swz % 64) / 2; }
__host__ __device__ __forceinline__ int perm32(int rho) { const int n = rho >> 4, i = rho & 15; return 8 * (i >> 2) + 4 * n + (i & 3); }

struct Unit { int pm, pn; };
struct Gemm { const bf16_t* A; const bf16_t* Bt; int M, N, K, amode; };

struct StaticOrder {
    int nM, nN, nwg, G, c;
    __host__ __device__ void init(int M, int N, int G_, int c_) { nM = M / BM; nN = N / BM; nwg = nM * nN; G = G_; c = c_; }
    __host__ __device__ bool next(int i, Unit& u) const {
        const long L = (long)i * G + c; if (L >= nwg) return false;
        int wgid = (int)L; { const int q = nwg / NXCD, r = nwg % NXCD, xcd = wgid % NXCD, off = wgid / NXCD; wgid = (xcd < r ? xcd * (q + 1) : r * (q + 1) + (xcd - r) * q) + off; }
        const int nig = WGM * nN, gid = wgid / nig, fm = gid * WGM, gsz = (nM - fm) < WGM ? (nM - fm) : WGM;
        u.pm = fm + ((wgid % nig) % gsz); u.pn = (wgid % nig) / gsz; return true;
    }
    __device__ __forceinline__ void a_ready(const Unit&) const {}
    __device__ __forceinline__ void done(const Unit&) const {}
};


__device__ __forceinline__ unsigned cvt_pk_bf16(float lo, float hi) { unsigned r; asm volatile("v_cvt_pk_bf16_f32 %0, %1, %2" : "=v"(r) : "v"(lo), "v"(hi)); return r; }
template <class Epi, class Sched, bool ALIGN_EPI = false, bool SP2 = false>
__device__ __forceinline__ void gemm_phase(PG8_LAS unsigned char* lds, const Gemm g, const Sched& S, const Epi& E) {
    int tid_ = threadIdx.x; asm volatile("" : "+v"(tid_)); const int tid = tid_, wid = __builtin_amdgcn_readfirstlane(tid >> 6), lane = tid & 63, wr = wid >> 2, wc = wid & 3, fr = lane & 15, fq = lane >> 4;
    const int K = g.K, nt = K / BK;
    unsigned voffA[2], voffB[2];
#pragma unroll
    for (int i = 0; i < 2; ++i) { int R, C; stage_rc(tid * 16 + i * 8192, R, C); const int Rb = Epi::PERM ? ((R & ~31) + perm32(R & 31)) : R;
        const int Ra = (g.amode != 0) ? (((R >> 6) ? (g.amode == 2 ? 124 : 126) : 0) + 8 * (R & 15) + ((R >> 4) & 3)) : R;
        voffA[i] = (unsigned)(Ra * K + C) * 2u; voffB[i] = (unsigned)(Rb * K + C) * 2u; }
    const size_t kstep = (size_t)(BK * 2);
    const size_t hstep = (size_t)HALF * K * 2;
    const size_t tstep = 2 * hstep;
    const size_t hstepA = (g.amode != 0) ? (size_t)4 * K * 2 : hstep;
#define PG8_ABASE(pm_) ((g.amode == 1) ? ((const char*)g.A + ((ptrdiff_t)((pm_) / 33) * 8192 + (ptrdiff_t)((pm_) % 33) * 252 - 1) * (ptrdiff_t)K * 2) : (g.amode == 2) ? ((const char*)g.A + ((ptrdiff_t)((pm_) / 34) * 8192 + (ptrdiff_t)((pm_) % 34) * 248 - 2) * (ptrdiff_t)K * 2) : ((const char*)g.A + (size_t)(pm_) * tstep))
    const unsigned ldsw = (unsigned)wid * 1024u;
    const int aoff = lds_byte(wr * 64 + fr, fq * 8), boff = lds_byte(wc * 32 + fr, fq * 8);
#define PG8_SA(b, h) (((b) * 2 + (h)) * HTB)
#define PG8_SB(b, h) ((4 + (b) * 2 + (h)) * HTB)
#define PG8_STAGE(bufoff, gbase, voff) do { _Pragma("unroll") for (int _i = 0; _i < 2; ++_i) \
        __builtin_amdgcn_global_load_lds((const unsigned*)((const char*)(gbase) + (voff)[_i]), (PG8_LAS unsigned*)(lds + (bufoff) + ldsw + _i * 8192), 16, 0, 0); } while (0)
#define PG8_LDA(dst, b, h) do { _Pragma("unroll") for (int m = 0; m < 4; ++m) _Pragma("unroll") for (int k = 0; k < 2; ++k) dst[m][k] = *(const PG8_LAS bf16x8*)(lds + PG8_SA(b, h) + aoff + m * 2048 + k * 1024); } while (0)
#define PG8_LDB(dst, b, h) do { _Pragma("unroll") for (int n = 0; n < 2; ++n) _Pragma("unroll") for (int k = 0; k < 2; ++k) dst[n][k] = *(const PG8_LAS bf16x8*)(lds + PG8_SB(b, h) + boff + n * 2048 + k * 1024); } while (0)
#define PG8_MMA(ai, bj, At, Bt) do { __builtin_amdgcn_s_setprio(1); _Pragma("unroll") for (int m = 0; m < 4; ++m) _Pragma("unroll") for (int n = 0; n < 2; ++n) _Pragma("unroll") for (int k = 0; k < 2; ++k) \
        acc[ai][bj][m][n] = __builtin_amdgcn_mfma_f32_16x16x32_bf16(Bt[n][k], At[m][k], acc[ai][bj][m][n], 0, 0, 0); __builtin_amdgcn_s_setprio(0); } while (0)
#define PG8_WAIT_V(n) asm volatile("s_waitcnt vmcnt(" #n ")" ::: "memory")
#define PG8_WAIT_L(n) asm volatile("s_waitcnt lgkmcnt(" #n ")" ::: "memory")
#define PG8_BAR __builtin_amdgcn_s_barrier()
#define PG8_SCHED __builtin_amdgcn_sched_barrier(0)
    Unit cur, nxt; int ui = 0;
    if (!S.next(0, cur)) return;
    f32x4 acc[2][2][4][2];
#pragma unroll
    for (int a = 0; a < 2; ++a)
#pragma unroll
        for (int b = 0; b < 2; ++b)
#pragma unroll
            for (int m = 0; m < 4; ++m)
#pragma unroll
                for (int n = 0; n < 2; ++n) acc[a][b][m][n] = (f32x4){0.f, 0.f, 0.f, 0.f};
    bf16x8 At[4][2], B0[2][2], B1[2][2];
    const char* cA = PG8_ABASE(cur.pm); const char* cB = (const char*)g.Bt + (size_t)cur.pn * tstep;
    S.a_ready(cur);
    if constexpr (SP2) {
        PG8_STAGE(PG8_SB(0, 0), cB, voffB); PG8_STAGE(PG8_SB(0, 1), cB + hstep, voffB); PG8_STAGE(PG8_SA(0, 0), cA, voffA); PG8_STAGE(PG8_SA(0, 1), cA + hstepA, voffA);
        if (wr == 1) PG8_BAR;
        PG8_WAIT_V(2); PG8_BAR;
        PG8_STAGE(PG8_SB(1, 0), cB + kstep, voffB); PG8_STAGE(PG8_SA(1, 0), cA + kstep, voffA); PG8_STAGE(PG8_SB(1, 1), cB + hstep + kstep, voffB);
        PG8_WAIT_V(6); PG8_BAR;
    } else {
        PG8_STAGE(PG8_SB(0, 0), cB, voffB); PG8_STAGE(PG8_SA(0, 0), cA, voffA); PG8_STAGE(PG8_SB(0, 1), cB + hstep, voffB); PG8_STAGE(PG8_SA(0, 1), cA + hstepA, voffA);
        if (wr == 1) PG8_BAR;
        PG8_WAIT_V(4); PG8_BAR;
        PG8_STAGE(PG8_SB(1, 0), cB + kstep, voffB); PG8_STAGE(PG8_SA(1, 0), cA + kstep, voffA); PG8_STAGE(PG8_SB(1, 1), cB + hstep + kstep, voffB);
        PG8_WAIT_V(6); PG8_BAR;
    }
    for (;;) {
        const bool has_next = S.next(ui + 1, nxt);
        const char* nA = has_next ? PG8_ABASE(nxt.pm) : cA; const char* nB = has_next ? (const char*)g.Bt + (size_t)nxt.pn * tstep : cB;
        for (int t = 0; t < nt; t += 2) {
            const bool last = (t == nt - 2);
            const char* a1 = cA + (size_t)(t + 1) * kstep;
            const char* a2 = last ? nA : cA + (size_t)(t + 2) * kstep; const char* b2 = last ? nB : cB + (size_t)(t + 2) * kstep;
            const char* a3 = a2 + kstep; const char* b3 = b2 + kstep;
            if (last && has_next) S.a_ready(nxt);
            if constexpr (SP2) {
            PG8_LDB(B0, 0, 0); PG8_LDB(B1, 0, 1); PG8_SCHED; PG8_LDA(At, 0, 0); PG8_STAGE(PG8_SA(1, 1), a1 + hstepA, voffA);
            PG8_WAIT_V(8); PG8_WAIT_L(0); PG8_BAR; PG8_MMA(0, 0, At, B0); PG8_MMA(0, 1, At, B1); PG8_BAR; PG8_SCHED;
            PG8_LDA(At, 0, 1); PG8_STAGE(PG8_SB(0, 0), b2, voffB); PG8_STAGE(PG8_SB(0, 1), b2 + hstep, voffB); PG8_STAGE(PG8_SA(0, 0), a2, voffA);
            PG8_WAIT_V(8); PG8_WAIT_L(0); PG8_BAR; PG8_MMA(1, 0, At, B0); PG8_MMA(1, 1, At, B1); PG8_BAR; PG8_SCHED;
            PG8_LDB(B0, 1, 0); PG8_LDB(B1, 1, 1); PG8_SCHED; PG8_LDA(At, 1, 0); PG8_STAGE(PG8_SA(0, 1), a2 + hstepA, voffA);
            PG8_WAIT_V(8); PG8_WAIT_L(0); PG8_BAR; PG8_MMA(0, 0, At, B0); PG8_MMA(0, 1, At, B1); PG8_BAR; PG8_SCHED;
            PG8_LDA(At, 1, 1); PG8_STAGE(PG8_SB(1, 0), b3, voffB); PG8_STAGE(PG8_SB(1, 1), b3 + hstep, voffB); PG8_STAGE(PG8_SA(1, 0), a3, voffA);
            PG8_WAIT_V(8); PG8_WAIT_L(0); PG8_BAR; PG8_MMA(1, 0, At, B0); PG8_MMA(1, 1, At, B1); PG8_BAR; PG8_SCHED;
            } else {
            PG8_LDB(B0, 0, 0); PG8_SCHED; PG8_LDA(At, 0, 0); PG8_STAGE(PG8_SA(1, 1), a1 + hstepA, voffA);
            PG8_WAIT_L(8); PG8_BAR; PG8_WAIT_L(0); PG8_MMA(0, 0, At, B0); PG8_BAR; PG8_SCHED;
            PG8_LDB(B1, 0, 1); PG8_STAGE(PG8_SB(0, 0), b2, voffB);
            PG8_BAR; PG8_WAIT_L(0); PG8_MMA(0, 1, At, B1); PG8_BAR;
            PG8_LDA(At, 0, 1); PG8_STAGE(PG8_SA(0, 0), a2, voffA);
            PG8_BAR; PG8_WAIT_L(0); PG8_MMA(1, 0, At, B0); PG8_BAR; PG8_SCHED;
            PG8_STAGE(PG8_SB(0, 1), b2 + hstep, voffB);
            PG8_WAIT_V(6); PG8_BAR; PG8_MMA(1, 1, At, B1); PG8_BAR;
            PG8_LDB(B0, 1, 0); PG8_SCHED; PG8_LDA(At, 1, 0); PG8_STAGE(PG8_SA(0, 1), a2 + hstepA, voffA);
            PG8_WAIT_L(8); PG8_BAR; PG8_WAIT_L(0); PG8_MMA(0, 0, At, B0); PG8_BAR; PG8_SCHED;
            PG8_LDB(B1, 1, 1); PG8_STAGE(PG8_SB(1, 0), b3, voffB);
            PG8_BAR; PG8_WAIT_L(0); PG8_MMA(0, 1, At, B1); PG8_BAR;
            PG8_LDA(At, 1, 1); PG8_STAGE(PG8_SA(1, 0), a3, voffA);
            PG8_BAR; PG8_WAIT_L(0); PG8_MMA(1, 0, At, B0); PG8_BAR; PG8_SCHED;
            PG8_STAGE(PG8_SB(1, 1), b3 + hstep, voffB);
            PG8_WAIT_V(6); PG8_BAR; PG8_MMA(1, 1, At, B1); PG8_BAR;
            }
        }
        if constexpr (ALIGN_EPI) { if (wr == 0) PG8_BAR; }
        if constexpr (!Epi::AFTER_DRAIN) { E(acc, cur, wr, wc, fr, fq); S.done(cur); }
        if (!has_next) break;
#pragma unroll
        for (int a = 0; a < 2; ++a)
#pragma unroll
            for (int b = 0; b < 2; ++b)
#pragma unroll
                for (int m = 0; m < 4; ++m)
#pragma unroll
                    for (int n = 0; n < 2; ++n) acc[a][b][m][n] = (f32x4){0.f, 0.f, 0.f, 0.f};
        cur = nxt; cA = nA; cB = nB; ++ui;
        if constexpr (ALIGN_EPI) { if (wr == 1) PG8_BAR; }
    }
    PG8_WAIT_V(0);
    if constexpr (!ALIGN_EPI) { if (wr == 0) PG8_BAR; }
    PG8_BAR;
    if constexpr (Epi::AFTER_DRAIN) { E.fused(acc, cur, wr, wc, fr, fq, lds, wid, lane); S.done(cur); }
#undef PG8_ABASE
#undef PG8_SA
#undef PG8_SB
#undef PG8_STAGE
#undef PG8_LDA
#undef PG8_LDB
#undef PG8_MMA
#undef PG8_WAIT_V
#undef PG8_WAIT_L
#undef PG8_BAR
#undef PG8_SCHED
}
}

constexpr int SEQ = 8192, NBATCH = 4, DM = 1024, MTOK = NBATCH * SEQ, MH = MTOK / 2;
constexpr int QKVD = 1536, DFF = 2816, DFF2 = 5632, DIN = 2048, CONVD = 4096, SSDIN = 6208, SSDINP = 6400;
constexpr float EPSF = 1e-6f;
typedef unsigned short bf16;
typedef pg8::f32x4 f32x4;
typedef pg8::u32x4 u32x4;
typedef unsigned u32x2 __attribute__((ext_vector_type(2)));

constexpr size_t MiB = 1u << 20;
constexpr size_t WS_SS = 500 * MiB;
constexpr size_t WS_BAR = 0;
constexpr size_t WS_SWP = 64 * 1024;
constexpr size_t WS_CWP = 1 * MiB;
constexpr size_t WS_ROPE = 1536 * 1024;
constexpr size_t WS_W = 2 * MiB;
constexpr size_t W_ATT_STRIDE = 5 * MiB, W_ATT_WO = 3 * MiB;
constexpr size_t W_SSD0 = 10 * MiB, W_SSD_STRIDE = 16 * MiB + 512 * 1024, W_SSD_WOUT = 12 * MiB + 512 * 1024;
constexpr size_t W_FFN0 = 43 * MiB, W_FFN_STRIDE = 16 * MiB + 512 * 1024, W_FFN_DOWN = 11 * MiB;
constexpr size_t WS_XB = 112 * MiB;
constexpr size_t WS_R = 176 * MiB;
constexpr size_t R_QKV = WS_R, R_OB = WS_R + 96 * MiB;
constexpr size_t R_ACT = WS_R;
constexpr size_t R_Z = WS_R, R_RAW = WS_R + 64 * MiB, R_CONV = WS_R + 192 * MiB, R_DT = WS_R + 320 * MiB;
constexpr size_t R_YF = R_RAW, R_YB = R_RAW + 64 * MiB;
constexpr size_t WS_END = 502 * MiB;
static_assert(WS_END <= 512 * MiB, "ws map");

enum { K_GEMM = 0, K_ATTN = 1, K_FCONV = 2, K_SCONV = 3, K_MARCH = 4, K_COMB = 5 };
struct Step { int kind, layer, sub, hb; };
constexpr int MAXSTEPS = 96;
constexpr int PROBE = 0;
constexpr int MPROBE = 0;
struct Args { const float* in[21]; float* out; unsigned char* ws; int nsteps; int pad; Step steps[MAXSTEPS]; };

__device__ __forceinline__ int wave_id() { return __builtin_amdgcn_readfirstlane((int)(threadIdx.x >> 6)); }
__device__ __forceinline__ int otid() { int t = threadIdx.x; asm volatile("" : "+v"(t)); return t; }
__device__ __forceinline__ float bflo(unsigned u) { return __uint_as_float(u << 16); }
__device__ __forceinline__ float bfhi(unsigned u) { return __uint_as_float(u & 0xffff0000u); }
typedef float f32x2_t __attribute__((ext_vector_type(2))); typedef __bf16 bf16x2_t __attribute__((ext_vector_type(2)));
__device__ __forceinline__ unsigned pk2(float lo, float hi) { f32x2_t v = {lo, hi}; bf16x2_t b = __builtin_convertvector(v, bf16x2_t); return __builtin_bit_cast(unsigned, b); }
__device__ __forceinline__ float bf1(bf16 v) { return __uint_as_float(((unsigned)v) << 16); }
__device__ __forceinline__ float up1_16(float v) { return __builtin_bit_cast(float, __builtin_amdgcn_update_dpp(__builtin_bit_cast(int, v), __builtin_bit_cast(int, v), 0x111, 0xf, 0xf, false)); }
__device__ __forceinline__ float dn1_16(float v) { return __builtin_bit_cast(float, __builtin_amdgcn_update_dpp(__builtin_bit_cast(int, v), __builtin_bit_cast(int, v), 0x101, 0xf, 0xf, false)); }
__device__ __forceinline__ float siluf(float x) { return x * __builtin_amdgcn_rcpf(1.f + __builtin_amdgcn_exp2f(-1.4426950408889634f * x)); }
__device__ __forceinline__ float wave_sum(float v) {
#pragma unroll
    for (int o = 1; o < 64; o <<= 1) v += __shfl_xor(v, o);
    return v;
}

struct EP { int mode, ld0, c0, ld1, c1, ld2, c2, pad; const float* ss_in; bf16* o0; bf16* o1; float* o2; const float* base; float* out; bf16* xb; float* ss_out; const float* cw; const float* cb; };
#define GAS1 __attribute__((address_space(1)))
struct EpiG {
    static constexpr bool PERM = true, AFTER_DRAIN = false;
    const PG8_LAS EP* ep;
    __device__ __forceinline__ void operator()(const f32x4 (&acc)[2][2][4][2], const pg8::Unit& u, int wr, int wc, int fr_, int fq_) const {
        int fr = fr_, fq = fq_; asm volatile("" : "+v"(fr), "+v"(fq));
        const int row0 = u.pm * 256 + wr * 64 + fr;
        const int colb = u.pn * 256 + wc * 32 + 8 * fq;
        const PG8_LAS EP* ep = this->ep; { unsigned epa = (unsigned)(size_t)ep; asm volatile("" : "+v"(epa)); ep = (const PG8_LAS EP*)(size_t)epa; }
        const int mode = ep->mode;
        if (mode == 0) {
            const GAS1 float* ss_in = (const GAS1 float*)ep->ss_in; GAS1 bf16* o0 = (GAS1 bf16*)ep->o0; GAS1 bf16* o1 = (GAS1 bf16*)ep->o1; GAS1 float* o2 = (GAS1 float*)ep->o2;
            const int ld0 = ep->ld0, c0 = ep->c0, ld1 = ep->ld1, c1 = ep->c1, ld2 = ep->ld2, c2 = ep->c2;
            f32x4 ppa[2][4];
#pragma unroll
            for (int ai = 0; ai < 2; ++ai)
#pragma unroll
                for (int m = 0; m < 4; ++m) ppa[ai][m] = *(const GAS1 f32x4*)(ss_in + (size_t)(row0 + ai * 128 + m * 16) * 4);
#pragma unroll
            for (int ai = 0; ai < 2; ++ai) {
                const f32x4 (&pp)[4] = ppa[ai];
#pragma unroll
                for (int m = 0; m < 4; ++m) {
                    const int row = row0 + ai * 128 + m * 16;
                    const float rs = rsqrtf(((pp[m][0] + pp[m][1]) + (pp[m][2] + pp[m][3])) * (1.0f / 1024.0f) + EPSF);
#pragma unroll
                    for (int bj = 0; bj < 2; ++bj) {
                        const int col = colb + bj * 128;
                        const f32x4 v0 = acc[ai][bj][m][0] * rs, v1 = acc[ai][bj][m][1] * rs;
                        if (col < c1) {
                            u32x4 w; w.x = pk2(v0[0], v0[1]); w.y = pk2(v0[2], v0[3]); w.z = pk2(v1[0], v1[1]); w.w = pk2(v1[2], v1[3]);
                            if (col < c0) *(GAS1 u32x4*)(o0 + (size_t)row * ld0 + col) = w;
                            else *(GAS1 u32x4*)(o1 + (size_t)row * ld1 + (col - c0)) = w;
                        } else if (col < c2) {
                            GAS1 float* p = o2 + (size_t)row * ld2 + (col - c1);
                            *(GAS1 f32x4*)p = v0; *(GAS1 f32x4*)(p + 4) = v1;
                        }
                    }
                }
                asm volatile("" ::: "memory");
            }
        } else if (mode == 4) {
            GAS1 bf16* o0 = (GAS1 bf16*)ep->o0; const int ld0 = ep->ld0;
#pragma unroll
            for (int ai = 0; ai < 2; ++ai)
#pragma unroll
                for (int m = 0; m < 4; ++m) { const int row = row0 + ai * 128 + m * 16;
#pragma unroll
                    for (int bj = 0; bj < 2; ++bj) { const f32x4 v0 = acc[ai][bj][m][0], v1 = acc[ai][bj][m][1];
                        u32x4 w; w.x = pk2(v0[0], v0[1]); w.y = pk2(v0[2], v0[3]); w.z = pk2(v1[0], v1[1]); w.w = pk2(v1[2], v1[3]);
                        *(GAS1 u32x4*)(o0 + (size_t)row * ld0 + colb + bj * 128) = w; } }
        } else if (mode == 2) {
            const GAS1 float* ss_in = (const GAS1 float*)ep->ss_in;
            const f32x4 pv2 = *(const GAS1 f32x4*)((const GAS1 float*)ep->cw + (size_t)((u.pn * 128 + wc * 32) >> 2) * 32 + (16 * fq + fr) * 4);
            const int sb = u.pm / 33, ti = u.pm - sb * 33;
            const int tok0 = 252 * ti - 1 + 126 * wr + 8 * fr;
            const size_t rowb = (size_t)sb * SEQ;
            float rs[8];
#pragma unroll
            for (int kb = 0; kb < 1; ++kb) {
                f32x4 pp[8]; bool okr[8];
#pragma unroll
                for (int kk = 0; kk < 8; ++kk) { const int tok = tok0 + kk; okr[kk] = tok >= 0 && tok < SEQ; const int tokc = okr[kk] ? tok : 0;
                    pp[kk] = *(const GAS1 f32x4*)(ss_in + (rowb + tokc) * 4); }
#pragma unroll
                for (int kk = 0; kk < 8; ++kk) { const float r = rsqrtf(((pp[kk][0] + pp[kk][1]) + (pp[kk][2] + pp[kk][3])) * (1.0f / 1024.0f) + EPSF);
                    float rk = okr[kk] ? r : 0.f; asm volatile("" : "+v"(rk)); rs[kk] = rk; }
            }
            GAS1 bf16* act = (GAS1 bf16*)ep->o0;
            PG8_LAS unsigned char* wl = (PG8_LAS unsigned char*)(size_t)(131072 + 256 + (wr * 4 + wc) * 1536);
            *(PG8_LAS f32x4*)(wl + (16 * fq + fr) * 16) = pv2;
#pragma unroll
            for (int kh = 0; kh < 2; ++kh) {
                unsigned outp[4][4];
#pragma unroll
                for (int q = 0; q < 4; ++q) {
                    const int n = q >> 1, e0 = 2 * (q & 1);
                    asm volatile("" : "+v"(rs[0]), "+v"(rs[1]), "+v"(rs[2]), "+v"(rs[3]), "+v"(rs[4]), "+v"(rs[5]), "+v"(rs[6]), "+v"(rs[7]));
                    typedef float f2 __attribute__((ext_vector_type(2)));
                    const PG8_LAS float* wp = (const PG8_LAS float*)(wl + ((2 * fq + n) * 32 + e0) * 4);
                    const f2 wg0 = *(const PG8_LAS f2*)(wp), wg1 = *(const PG8_LAS f2*)(wp + 4), wg2 = *(const PG8_LAS f2*)(wp + 8), bg = *(const PG8_LAS f2*)(wp + 12);
                    const f2 wv0 = *(const PG8_LAS f2*)(wp + 16), wv1 = *(const PG8_LAS f2*)(wp + 20), wv2 = *(const PG8_LAS f2*)(wp + 24), bv = *(const PG8_LAS f2*)(wp + 28);
#define SX(bj_, k_) ((f2){acc[(k_) >> 2][bj_][(k_) & 3][n][e0], acc[(k_) >> 2][bj_][(k_) & 3][n][e0 + 1]} * rs[k_])
                    f2 gm, gc, gp, vm, vc, vp, gl, vl;
                    if (kh == 0) { const f2 g7 = SX(0, 7), v7 = SX(1, 7);
                        gm[0] = up1_16(g7[0]); gm[1] = up1_16(g7[1]); vm[0] = up1_16(v7[0]); vm[1] = up1_16(v7[1]);
                        gl = SX(0, 4); vl = SX(1, 4); gc = SX(0, 0); vc = SX(1, 0);
                    } else { const f2 g0 = SX(0, 0), v0 = SX(1, 0);
                        gl[0] = dn1_16(g0[0]); gl[1] = dn1_16(g0[1]); vl[0] = dn1_16(v0[0]); vl[1] = dn1_16(v0[1]);
                        gm = SX(0, 3); vm = SX(1, 3); gc = SX(0, 4); vc = SX(1, 4); }
#pragma unroll
                    for (int kk = 0; kk < 4; ++kk) {
                        const int k = 4 * kh + kk;
                        if (kk < 3) { gp = SX(0, (kk < 3 ? k + 1 : k)); vp = SX(1, (kk < 3 ? k + 1 : k)); } else { gp = gl; vp = vl; }
                        const f2 G = bg + wg0 * gm + wg1 * gc + wg2 * gp, V = bv + wv0 * vm + wv1 * vc + wv2 * vp;
                        outp[kk][q] = pk2(siluf(G[0]) * V[0], siluf(G[1]) * V[1]);
                        gm = gc; gc = gp; vm = vc; vc = vp;
                    }
#undef SX
                    asm volatile("" : "+v"(outp[0][q]), "+v"(outp[1][q]), "+v"(outp[2][q]), "+v"(outp[3][q]) :: "memory");
                }
#pragma unroll
                for (int kk = 0; kk < 4; ++kk) { int kx = 4 * kh + kk; asm volatile("" : "+v"(kx));
                    const int sidx = 8 * fr + kx, tok = tok0 + kx;
                    if (sidx >= 1 && sidx <= 126 && tok < SEQ) { u32x4 w; w.x = outp[kk][0]; w.y = outp[kk][1]; w.z = outp[kk][2]; w.w = outp[kk][3];
                        *(GAS1 u32x4*)(act + (rowb + tok) * DFF + u.pn * 128 + wc * 32 + 8 * fq) = w; } }
                asm volatile("" ::: "memory");
            }
        } else if (mode == 3) {
            const GAS1 float* ss_in = (const GAS1 float*)ep->ss_in;
            f32x4 pv3a = {0.f, 0.f, 0.f, 0.f}, pv3b = {0.f, 0.f, 0.f, 0.f};
            if (u.pn >= 8 && u.pn < 24 && 16 * fq + fr < 48) { const GAS1 float* src = (const GAS1 float*)ep->cw + (size_t)((u.pn * 256 + wc * 32 - DIN) >> 2) * 24 + (16 * fq + fr) * 4; pv3a = *(const GAS1 f32x4*)src; pv3b = *(const GAS1 f32x4*)(src + 768); }
            const int sb = u.pm / 34, ti = u.pm - sb * 34;
            const int tok0 = 248 * ti - 2 + 124 * wr + 8 * fr;
            const size_t rowb = (size_t)sb * SEQ;
            float rs[8];
#pragma unroll
            for (int kb = 0; kb < 1; ++kb) {
                f32x4 pp[8]; bool okr[8];
#pragma unroll
                for (int kk = 0; kk < 8; ++kk) { const int tok = tok0 + kk; okr[kk] = tok >= 0 && tok < SEQ; const int tokc = okr[kk] ? tok : 0;
                    pp[kk] = *(const GAS1 f32x4*)(ss_in + (rowb + tokc) * 4); }
#pragma unroll
                for (int kk = 0; kk < 8; ++kk) { const float r = rsqrtf(((pp[kk][0] + pp[kk][1]) + (pp[kk][2] + pp[kk][3])) * (1.0f / 1024.0f) + EPSF);
                    float rk = okr[kk] ? r : 0.f; asm volatile("" : "+v"(rk)); rs[kk] = rk; }
            }
            if (u.pn < 8) {
                GAS1 bf16* zo = (GAS1 bf16*)ep->o0;
#pragma unroll
                for (int k = 0; k < 8; ++k) { int kx = k; asm volatile("" : "+v"(kx)); const int sidx = 8 * fr + kx, tok = tok0 + kx;
                    if (sidx >= 2 && sidx <= 125 && tok < SEQ) {
#pragma unroll
                        for (int bj = 0; bj < 2; ++bj) { const f32x4 v0 = acc[k >> 2][bj][k & 3][0] * rs[k], v1 = acc[k >> 2][bj][k & 3][1] * rs[k];
                            u32x4 w; w.x = pk2(v0[0], v0[1]); w.y = pk2(v0[2], v0[3]); w.z = pk2(v1[0], v1[1]); w.w = pk2(v1[2], v1[3]);
                            *(GAS1 u32x4*)(zo + (rowb + tok) * DIN + colb + bj * 128) = w; } } }
            } else if (u.pn == 24) {
                if (wc < 2) { GAS1 float* dto = (GAS1 float*)ep->o2; const GAS1 float* dtb = (const GAS1 float*)ep->cb; const int c0 = wc * 32 + 8 * fq;
                    const f32x4 b0 = *(const GAS1 f32x4*)(dtb + c0), b1 = *(const GAS1 f32x4*)(dtb + c0 + 4);
#pragma unroll
                    for (int k = 0; k < 8; ++k) { int kx = k; asm volatile("" : "+v"(kx)); const int sidx = 8 * fr + kx, tok = tok0 + kx;
                        if (sidx >= 2 && sidx <= 125 && tok < SEQ) { f32x4 v0 = acc[k >> 2][0][k & 3][0] * rs[k] + b0, v1 = acc[k >> 2][0][k & 3][1] * rs[k] + b1;
#pragma unroll
                            for (int e = 0; e < 4; ++e) { v0[e] = fmaxf(v0[e], 0.f) + __logf(1.f + __expf(-fabsf(v0[e]))); v1[e] = fmaxf(v1[e], 0.f) + __logf(1.f + __expf(-fabsf(v1[e]))); }
                            GAS1 float* p = dto + (rowb + tok) * 64 + c0; *(GAS1 f32x4*)p = v0; *(GAS1 f32x4*)(p + 4) = v1; } } }
            } else {
                GAS1 bf16* co = (GAS1 bf16*)ep->o1;
                const int cc0 = colb - DIN;
                unsigned sbase[2]; const unsigned sstride = (cc0 < 2048) ? 32u : 256u;
#pragma unroll
                for (int bj = 0; bj < 2; ++bj) { const unsigned cc = (unsigned)(cc0 + bj * 128);
                    sbase[bj] = (cc < 2048u) ? ((cc >> 5) * (unsigned)(MH * 32) + (cc & 31u)) : (2048u * MH + (((cc - 2048u) & 1023u) >> 7) * (unsigned)(MH * 256) + ((cc >= 3072u) ? 128u : 0u) + (cc & 127u)); }
                PG8_LAS unsigned char* wl = (PG8_LAS unsigned char*)(size_t)(131072 + 256 + (wr * 4 + wc) * 1536);
                { const int ln = 16 * fq + fr; if (ln < 48) { *(PG8_LAS f32x4*)(wl + ln * 16) = pv3a; *(PG8_LAS f32x4*)(wl + 768 + ln * 16) = pv3b; } }
#pragma unroll
                for (int kh = 0; kh < 2; ++kh) {
#pragma unroll
                  for (int bj = 0; bj < 2; ++bj) {
                    unsigned outp[4][4];
#pragma unroll
                    for (int q = 0; q < 4; ++q) {
                        const int n = q >> 1, e0 = 2 * (q & 1);
                        asm volatile("" : "+v"(rs[0]), "+v"(rs[1]), "+v"(rs[2]), "+v"(rs[3]), "+v"(rs[4]), "+v"(rs[5]), "+v"(rs[6]), "+v"(rs[7]));
                        typedef float f2 __attribute__((ext_vector_type(2)));
                        const PG8_LAS float* wp = (const PG8_LAS float*)(wl + bj * 768 + ((2 * fq + n) * 24 + e0) * 4);
                        const f2 w0 = *(const PG8_LAS f2*)(wp), w1 = *(const PG8_LAS f2*)(wp + 4), w2 = *(const PG8_LAS f2*)(wp + 8), w3 = *(const PG8_LAS f2*)(wp + 12), w4 = *(const PG8_LAS f2*)(wp + 16), bb = *(const PG8_LAS f2*)(wp + 20);
#define SX(k_) ((f2){acc[(k_) >> 2][bj][(k_) & 3][n][e0], acc[(k_) >> 2][bj][(k_) & 3][n][e0 + 1]} * rs[k_])
                        f2 ha, hb, hc, hd, he, t1, t2;
                        if (kh == 0) { const f2 s6 = SX(6), s7 = SX(7);
                            ha[0] = up1_16(s6[0]); ha[1] = up1_16(s6[1]); hb[0] = up1_16(s7[0]); hb[1] = up1_16(s7[1]);
                            hc = SX(0); hd = SX(1); he = SX(2); t1 = SX(4); t2 = SX(5);
                        } else { const f2 s0 = SX(0), s1 = SX(1);
                            t1[0] = dn1_16(s0[0]); t1[1] = dn1_16(s0[1]); t2[0] = dn1_16(s1[0]); t2[1] = dn1_16(s1[1]);
                            ha = SX(2); hb = SX(3); hc = SX(4); hd = SX(5); he = SX(6); }
#pragma unroll
                        for (int kk = 0; kk < 4; ++kk) {
                            const f2 v = bb + w0 * ha + w1 * hb + w2 * hc + w3 * hd + w4 * he;
                            outp[kk][q] = pk2(siluf(v[0]), siluf(v[1]));
                            ha = hb; hb = hc; hc = hd; hd = he;
                            he = (kk == 0) ? SX((kh == 0) ? 3 : 7) : (kk == 1) ? t1 : t2;
                        }
#undef SX
                        asm volatile("" : "+v"(outp[0][q]), "+v"(outp[1][q]), "+v"(outp[2][q]), "+v"(outp[3][q]) :: "memory");
                    }
#pragma unroll
                    for (int kk = 0; kk < 4; ++kk) { int kx = 4 * kh + kk; asm volatile("" : "+v"(kx));
                        const int sidx = 8 * fr + kx, tok = tok0 + kx;
                        if (sidx >= 2 && sidx <= 125 && tok < SEQ) {
                            u32x4 wa; wa.x = outp[kk][0]; wa.y = outp[kk][1]; wa.z = outp[kk][2]; wa.w = outp[kk][3];
                            *(GAS1 u32x4*)(co + (sbase[bj] + (unsigned)(rowb + tok) * sstride)) = wa; } }
                    asm volatile("" ::: "memory");
                  }
                }
            }
        } else {
            GAS1 float* out = (GAS1 float*)ep->out; GAS1 bf16* xb = (GAS1 bf16*)ep->xb; GAS1 float* ss_out = (GAS1 float*)ep->ss_out;
#pragma unroll
            for (int ai = 0; ai < 2; ++ai) {
                u32x4 bb[4][2];
#pragma unroll
                for (int m = 0; m < 4; ++m)
#pragma unroll
                    for (int bj = 0; bj < 2; ++bj) bb[m][bj] = *(const GAS1 u32x4*)(xb + (size_t)(row0 + ai * 128 + m * 16) * 1024 + colb + bj * 128);
#pragma unroll
                for (int m = 0; m < 4; ++m) {
                    const int row = row0 + ai * 128 + m * 16;
                    float sq = 0.f;
#pragma unroll
                    for (int bj = 0; bj < 2; ++bj) {
                        const size_t off = (size_t)row * 1024 + colb + bj * 128; const u32x4 bw = bb[m][bj];
                        const f32x4 b0 = {bflo(bw.x), bfhi(bw.x), bflo(bw.y), bfhi(bw.y)}, b1 = {bflo(bw.z), bfhi(bw.z), bflo(bw.w), bfhi(bw.w)};
                        const f32x4 v0 = acc[ai][bj][m][0] + b0, v1 = acc[ai][bj][m][1] + b1;
                        if (out) { *(GAS1 f32x4*)(out + off) = v0; *(GAS1 f32x4*)(out + off + 4) = v1; }
                        u32x4 w; w.x = pk2(v0[0], v0[1]); w.y = pk2(v0[2], v0[3]); w.z = pk2(v1[0], v1[1]); w.w = pk2(v1[2], v1[3]);
                        *(GAS1 u32x4*)(xb + off) = w;
                        const f32x4 r0 = {bflo(w.x), bfhi(w.x), bflo(w.y), bfhi(w.y)}, r1 = {bflo(w.z), bfhi(w.z), bflo(w.w), bfhi(w.w)};
                        sq += (r0[0] * r0[0] + r0[1] * r0[1]) + (r0[2] * r0[2] + r0[3] * r0[3]) + (r1[0] * r1[0] + r1[1] * r1[1]) + (r1[2] * r1[2] + r1[3] * r1[3]);
                    }
                    sq += __shfl_xor(sq, 16); sq += __shfl_xor(sq, 32);
                    if (fq == 0) *(PG8_LAS float*)(size_t)(131328 + ((ai * 128 + wr * 64 + m * 16 + fr) * 4 + wc) * 4) = sq;
                }
                asm volatile("" ::: "memory");
            }
            asm volatile("s_waitcnt lgkmcnt(0)\n\ts_barrier" ::: "memory");
            if (fq < 2) { const int rl = (wr * 4 + wc) * 32 + 16 * fq + fr; const f32x4 q = *(const PG8_LAS f32x4*)(size_t)(131328 + rl * 16);
                ss_out[(size_t)(u.pm * 256 + rl) * 4 + u.pn] = (q[0] + q[1]) + (q[2] + q[3]); }
        }
    }
};

__device__ __forceinline__ void p0_transpose_item(const float* W, const float* g, int K, int N, bf16* WT, float* scr, int item, int lane, int permup) {
    const int nblk = N / 32, kb = item / nblk, nb = item % nblk, k0 = 64 * kb, n0 = 32 * nb;
    float wv[32];
#pragma unroll
    for (int i = 0; i < 32; ++i) wv[i] = __builtin_nontemporal_load(&W[(size_t)(k0 + 2 * i + (lane >> 5)) * N + n0 + (lane & 31)]);
#pragma unroll
    for (int i = 0; i < 32; ++i) { const int kk = 2 * i + (lane >> 5); float v = wv[i]; if (g) v *= g[k0 + kk]; scr[kk * 33 + (lane & 31)] = v; }
    asm volatile("s_waitcnt lgkmcnt(0)" ::: "memory");
    const int c = lane & 7;
#pragma unroll
    for (int j = 0; j < 4; ++j) { const int n = (lane >> 3) + 8 * j; const float* s = scr + (8 * c) * 33 + n;
        u32x4 o; o.x = pk2(s[0 * 33], s[1 * 33]); o.y = pk2(s[2 * 33], s[3 * 33]); o.z = pk2(s[4 * 33], s[5 * 33]); o.w = pk2(s[6 * 33], s[7 * 33]);
        int nr = n0 + n; if (permup) { const int hv = nr >= DFF ? 1 : 0, jj = nr - hv * DFF; nr = 256 * (jj >> 7) + 128 * hv + (jj & 127); }
        *(u32x4*)(WT + (size_t)nr * K + k0 + 8 * c) = o; }
    asm volatile("s_waitcnt lgkmcnt(0)" ::: "memory");
}
__device__ __forceinline__ void p0_matrix(const float* W, const float* g, int K, int N, bf16* WT, float* scr, int gw, int NGW, int lane, int permup = 0) {
    const int nitems = (K / 64) * (N / 32);
    for (int it = gw; it < nitems; it += NGW) p0_transpose_item(W, g, K, N, WT, scr, it, lane, permup);
}

__device__ __forceinline__ void phase0(const Args& a, unsigned char* lds) {
    const int tid = otid(), lane = tid & 63, wave = tid >> 6;
    const int gw = blockIdx.x * 8 + wave, NGW = gridDim.x * 8;
    const int gt = blockIdx.x * 512 + tid, NGT = gridDim.x * 512;
    unsigned char* ws = a.ws;
    float* scr = (float*)(lds + wave * 16384);
    { float* rp = (float*)(ws + WS_ROPE);
      for (int i = gt; i < SEQ * 8; i += NGT) { const int pos = i >> 3, k = i & 7;
          const double invf = (k == 0) ? 1.0 : (k == 1) ? 0.19392274474868576 : (k == 2) ? 0.03760603093086393 : (k == 3) ? 0.007292664737217109 : (k == 4) ? 0.001414213562373095 : (k == 5) ? 0.0002742481756762073 : (k == 6) ? 5.318295896944988e-05 : 1.031338537721246e-05;
          const double rev = (double)pos * invf * 0.15915494309189535; const float fr = (float)(rev - rint(rev));
          rp[2 * i] = __builtin_amdgcn_cosf(fr); rp[2 * i + 1] = __builtin_amdgcn_sinf(fr); } }
    { float* cwp = (float*)(ws + WS_CWP);
      for (int i = gt; i < 4 * (DFF / 4) * 32; i += NGT) { const int e = i & 3, pp = (i >> 2) & 7, q = (i >> 5) % (DFF / 4), L = i / ((DFF / 4) * 32);
          const int j = 4 * q + e + ((pp >= 4) ? DFF : 0), p3 = pp & 3;
          cwp[i] = (p3 < 3) ? a.in[18][((size_t)L * 3 + p3) * DFF2 + j] : a.in[19][(size_t)L * DFF2 + j]; } }
    { float* swp = (float*)(ws + WS_SWP);
      for (int i = gt; i < 2 * (CONVD / 4) * 24; i += NGT) { const int L = i / ((CONVD / 4) * 24), r = i - L * ((CONVD / 4) * 24), q = r / 24, pp = (r % 24) >> 2, e = r & 3, c = 4 * q + e;
          swp[i] = (pp < 5) ? a.in[9][((size_t)L * 5 + pp) * CONVD + c] : a.in[10][(size_t)L * CONVD + c]; } }
    { u32x4* gz = (u32x4*)(ws + WS_XB - 2 * DM * 2); for (int i = gt; i < 2 * DM * 2 / 16; i += NGT) gz[i] = (u32x4){0u, 0u, 0u, 0u}; }
    { const float* x = a.in[0]; bf16* xb = (bf16*)(ws + WS_XB); float* ss = (float*)(ws + WS_SS);
      for (int m = gw; m < MTOK; m += NGW) { const f32x4* xr = (const f32x4*)(x + (size_t)m * DM) + lane; float s = 0.f;
          unsigned long long* o8 = (unsigned long long*)(xb + (size_t)m * DM) + lane;
#pragma unroll
          for (int j = 0; j < 4; ++j) { const f32x4 v = __builtin_nontemporal_load(&xr[64 * j]); s += (v.x * v.x + v.y * v.y) + (v.z * v.z + v.w * v.w);
              o8[64 * j] = (unsigned long long)pk2(v.x, v.y) | ((unsigned long long)pk2(v.z, v.w) << 32); }
          s = wave_sum(s); if (lane < 4) ss[(size_t)m * 4 + lane] = (lane == 0) ? s : 0.f; } }
    for (int j = 0; j < 2; ++j) {
        p0_matrix(a.in[2] + (size_t)j * DM * QKVD, a.in[1] + j * DM, DM, QKVD, (bf16*)(ws + WS_W + j * W_ATT_STRIDE), scr, gw, NGW, lane);
        p0_matrix(a.in[6] + (size_t)j * DM * DM, nullptr, DM, DM, (bf16*)(ws + WS_W + j * W_ATT_STRIDE + W_ATT_WO), scr, gw, NGW, lane);
        bf16* win = (bf16*)(ws + WS_W + W_SSD0 + j * W_SSD_STRIDE);
        p0_matrix(a.in[8] + (size_t)j * DM * SSDIN, a.in[7] + j * DM, DM, SSDIN, win, scr, gw, NGW, lane);
        { u32x4* z = (u32x4*)(win + (size_t)SSDIN * DM); const int n16 = (SSDINP - SSDIN) * DM * 2 / 16; for (int i = gt; i < n16; i += NGT) z[i] = (u32x4){0u, 0u, 0u, 0u}; }
        p0_matrix(a.in[15] + (size_t)j * DIN * DM, nullptr, DIN, DM, (bf16*)(ws + WS_W + W_SSD0 + j * W_SSD_STRIDE + W_SSD_WOUT), scr, gw, NGW, lane);
    }
    for (int i = 0; i < 4; ++i) {
        p0_matrix(a.in[17] + (size_t)i * DM * DFF2, a.in[16] + i * DM, DM, DFF2, (bf16*)(ws + WS_W + W_FFN0 + i * W_FFN_STRIDE), scr, gw, NGW, lane, 1);
        p0_matrix(a.in[20] + (size_t)i * DFF * DM, nullptr, DFF, DM, (bf16*)(ws + WS_W + W_FFN0 + i * W_FFN_STRIDE + W_FFN_DOWN), scr, gw, NGW, lane);
    }
}

#define LAS3 __attribute__((address_space(3)))
typedef short v4i16_t __attribute__((ext_vector_type(4)));
typedef float f32x16 __attribute__((ext_vector_type(16)));
typedef pg8::bf16x8 bf16x8;
constexpr int AT_RS = 144, AT_SK = 0, AT_SV = 384 * 144;
__device__ __forceinline__ void attn_phase(unsigned char* lds_g, const bf16* QKV, bf16* OB, const float* qg, const float* kg, const float* sink, const float* rope) {
    LAS3 unsigned char* lds = (LAS3 unsigned char*)lds_g;
    const int tid = otid(), lane = tid & 63, wave = __builtin_amdgcn_readfirstlane(tid >> 6);
    const int hi = lane >> 5, l32 = lane & 31, blk = (lane >> 4) & 1, q4 = (lane & 15) >> 2, p4 = lane & 3;
    constexpr float LOG2E = 1.4426950408889634f;
    for (int u = blockIdx.x; u < 1024; u += gridDim.x) {
        const int kvh = u & 3, n = (u >> 2) & 63, b = u >> 8;
        __syncthreads();
        { const int sub = tid & 7, r = tid >> 3;
          float kgv[8];
#pragma unroll
          for (int i = 0; i < 8; ++i) kgv[i] = kg[sub * 8 + i];
          u32x4 krs[6], vrs[6];
#pragma unroll
          for (int pass = 0; pass < 6; ++pass) { const int kpos = n * 128 - 128 + pass * 64 + r; const int kc = kpos < 0 ? 0 : (kpos >= SEQ ? SEQ - 1 : kpos);
              const size_t grow = (size_t)b * SEQ + kc;
              krs[pass] = *(const u32x4*)(QKV + grow * QKVD + 1024 + kvh * 64 + sub * 8);
              vrs[pass] = *(const u32x4*)(QKV + grow * QKVD + 1280 + kvh * 64 + sub * 8); }
#pragma unroll
          for (int pass = 0; pass < 6; ++pass) {
              const int jrow = pass * 64 + r, kpos = n * 128 - 128 + jrow;
              if (kpos >= 0 && kpos < SEQ) {
                  const u32x4 kr = krs[pass], vr = vrs[pass];
                  float k[8]; k[0] = bflo(kr.x); k[1] = bfhi(kr.x); k[2] = bflo(kr.y); k[3] = bfhi(kr.y); k[4] = bflo(kr.z); k[5] = bfhi(kr.z); k[6] = bflo(kr.w); k[7] = bfhi(kr.w);
                  float ss = 0.f;
#pragma unroll
                  for (int i = 0; i < 8; ++i) ss += k[i] * k[i];
                  ss += __shfl_xor(ss, 1); ss += __shfl_xor(ss, 2); ss += __shfl_xor(ss, 4);
                  const float rs = rsqrtf(ss * (1.0f / 64.0f) + EPSF);
#pragma unroll
                  for (int i = 0; i < 8; ++i) k[i] = k[i] * rs * kgv[i];
                  if (sub < 2) {
                      const float* rp = rope + (size_t)kpos * 16;
#pragma unroll
                      for (int i = 0; i < 8; ++i) { const float oth = __shfl_xor(k[i], 1); const float c = rp[2 * i], sn = rp[2 * i + 1];
                          k[i] = (sub == 0) ? (k[i] * c - oth * sn) : (k[i] * c + oth * sn); } }
                  u32x4 w; w.x = pk2(k[0], k[1]); w.y = pk2(k[2], k[3]); w.z = pk2(k[4], k[5]); w.w = pk2(k[6], k[7]);
                  *(LAS3 u32x4*)(lds + AT_SK + jrow * AT_RS + sub * 16) = w;
                  *(LAS3 u32x4*)(lds + AT_SV + jrow * AT_RS + sub * 16) = vr;
              }
          }
        }
        const int g = wave >> 1, head = kvh * 4 + g, i0 = 64 * (wave & 1);
        bf16x8 qf[2][4];
#pragma unroll
        for (int t = 0; t < 2; ++t) {
            const int qpos = n * 128 + i0 + 32 * t + l32; const size_t qrow = (size_t)b * SEQ + qpos;
            float qv[4][8]; float ss = 0.f;
#pragma unroll
            for (int ds = 0; ds < 4; ++ds) { const u32x4 w = *(const u32x4*)(QKV + qrow * QKVD + head * 64 + 16 * ds + 8 * hi);
                qv[ds][0] = bflo(w.x); qv[ds][1] = bfhi(w.x); qv[ds][2] = bflo(w.y); qv[ds][3] = bfhi(w.y); qv[ds][4] = bflo(w.z); qv[ds][5] = bfhi(w.z); qv[ds][6] = bflo(w.w); qv[ds][7] = bfhi(w.w);
#pragma unroll
                for (int jj = 0; jj < 8; ++jj) ss += qv[ds][jj] * qv[ds][jj]; }
            ss += __shfl_xor(ss, 32);
            const float rs = rsqrtf(ss * (1.0f / 64.0f) + EPSF);
#pragma unroll
            for (int ds = 0; ds < 4; ++ds)
#pragma unroll
                for (int jj = 0; jj < 8; ++jj) qv[ds][jj] = qv[ds][jj] * rs * qg[16 * ds + 8 * hi + jj];
            const float* rp = rope + (size_t)qpos * 16;
#pragma unroll
            for (int jj = 0; jj < 8; ++jj) { const float oth = __shfl_xor(qv[0][jj], 32); const float c = rp[2 * jj], sn = rp[2 * jj + 1];
                qv[0][jj] = hi ? (qv[0][jj] * c + oth * sn) : (qv[0][jj] * c - oth * sn); }
#pragma unroll
            for (int ds = 0; ds < 4; ++ds) { u32x4 w; const float sc = 0.125f * LOG2E;
                w.x = pk2(qv[ds][0] * sc, qv[ds][1] * sc); w.y = pk2(qv[ds][2] * sc, qv[ds][3] * sc); w.z = pk2(qv[ds][4] * sc, qv[ds][5] * sc); w.w = pk2(qv[ds][6] * sc, qv[ds][7] * sc);
                qf[t][ds] = __builtin_bit_cast(bf16x8, w); }
        }
        const float sink2 = sink[head] * LOG2E;
        float mrun[2] = {sink2, sink2}, lrun[2] = {hi ? 0.f : 1.f, hi ? 0.f : 1.f};
        f32x16 O[2][2];
#pragma unroll
        for (int t = 0; t < 2; ++t)
#pragma unroll
            for (int dt = 0; dt < 2; ++dt)
#pragma unroll
                for (int i = 0; i < 16; ++i) O[t][dt][i] = 0.f;
        __syncthreads();
        const int jlo = (n == 0) ? 128 : 0, jhi = (n == 63) ? 256 : 384;
        for (int jt = 0; jt < 10; ++jt) {
            const int jk = i0 + 32 * jt;
            if (jk < jlo || jk >= jhi) continue;
            bf16x8 kf[4], vf[2][2];
#pragma unroll
            for (int ds = 0; ds < 4; ++ds) kf[ds] = *(const LAS3 bf16x8*)(lds + AT_SK + (jk + l32) * AT_RS + (16 * ds + 8 * hi) * 2);
#pragma unroll
            for (int dt = 0; dt < 2; ++dt)
#pragma unroll
                for (int ks = 0; ks < 2; ++ks) {
                    const int off0 = (jk + 16 * ks + 4 * hi + q4) * AT_RS + (32 * dt + 16 * blk + 4 * p4) * 2;
                    const v4i16_t lo = __builtin_amdgcn_ds_read_tr16_b64_v4i16((LAS3 v4i16_t*)(lds + AT_SV + off0));
                    const v4i16_t hh = __builtin_amdgcn_ds_read_tr16_b64_v4i16((LAS3 v4i16_t*)(lds + AT_SV + off0 + 8 * AT_RS));
                    vf[dt][ks] = (bf16x8){lo[0], lo[1], lo[2], lo[3], hh[0], hh[1], hh[2], hh[3]};
                }
#pragma unroll
            for (int t = 0; t < 2; ++t) {
                if (jt < t || jt >= 9 + t) continue;
                f32x16 S;
#pragma unroll
                for (int i = 0; i < 16; ++i) S[i] = 0.f;
#pragma unroll
                for (int ds = 0; ds < 4; ++ds) S = __builtin_amdgcn_mfma_f32_32x32x16_bf16(kf[ds], qf[t][ds], S, 0, 0, 0);
                if (jt == t) {
#pragma unroll
                    for (int r = 0; r < 16; ++r) { const int kvrel = (r & 3) + 8 * (r >> 2) + 4 * hi; if (kvrel < l32) S[r] = -1e30f; }
                } else if (jt == t + 8) {
#pragma unroll
                    for (int r = 0; r < 16; ++r) { const int kvrel = (r & 3) + 8 * (r >> 2) + 4 * hi; if (kvrel > l32) S[r] = -1e30f; }
                }
                float tmax = S[0];
#pragma unroll
                for (int r = 1; r < 16; ++r) tmax = fmaxf(tmax, S[r]);
                tmax = fmaxf(tmax, __shfl_xor(tmax, 32));
                if (__any(tmax > mrun[t])) {
                    const float mnew = fmaxf(mrun[t], tmax), corr = __builtin_amdgcn_exp2f(mrun[t] - mnew);
                    lrun[t] *= corr; mrun[t] = mnew;
#pragma unroll
                    for (int dt = 0; dt < 2; ++dt)
#pragma unroll
                        for (int i = 0; i < 16; ++i) O[t][dt][i] *= corr;
                }
                float ps = 0.f;
#pragma unroll
                for (int r = 0; r < 16; ++r) { S[r] = __builtin_amdgcn_exp2f(S[r] - mrun[t]); ps += S[r]; }
                lrun[t] += ps;
#pragma unroll
                for (int ks = 0; ks < 2; ++ks) {
                    u32x4 w; w.x = pk2(S[8 * ks], S[8 * ks + 1]); w.y = pk2(S[8 * ks + 2], S[8 * ks + 3]); w.z = pk2(S[8 * ks + 4], S[8 * ks + 5]); w.w = pk2(S[8 * ks + 6], S[8 * ks + 7]);
                    const bf16x8 pb = __builtin_bit_cast(bf16x8, w);
#pragma unroll
                    for (int dt = 0; dt < 2; ++dt) O[t][dt] = __builtin_amdgcn_mfma_f32_32x32x16_bf16(vf[dt][ks], pb, O[t][dt], 0, 0, 0);
                }
            }
        }
#pragma unroll
        for (int t = 0; t < 2; ++t) {
            const float ltot = lrun[t] + __shfl_xor(lrun[t], 32), il = 1.f / ltot;
            const size_t qrow = (size_t)b * SEQ + n * 128 + i0 + 32 * t + l32;
#pragma unroll
            for (int dt = 0; dt < 2; ++dt)
#pragma unroll
                for (int i4 = 0; i4 < 4; ++i4) { u32x2 w; w.x = pk2(O[t][dt][4 * i4] * il, O[t][dt][4 * i4 + 1] * il); w.y = pk2(O[t][dt][4 * i4 + 2] * il, O[t][dt][4 * i4 + 3] * il);
                    *(u32x2*)(OB + qrow * DM + head * 64 + 32 * dt + 8 * i4 + 4 * hi) = w; }
        }
    }
}

__device__ __forceinline__ void ld8(const bf16* p, float (&v)[8]) { const u32x4 w = *(const u32x4*)p; v[0] = bflo(w.x); v[1] = bfhi(w.x); v[2] = bflo(w.y); v[3] = bfhi(w.y); v[4] = bflo(w.z); v[5] = bfhi(w.z); v[6] = bflo(w.w); v[7] = bfhi(w.w); }
__device__ __forceinline__ void ldf8(const float* p, float (&v)[8]) { const f32x4 a = *(const f32x4*)p, b = *(const f32x4*)(p + 4); v[0] = a.x; v[1] = a.y; v[2] = a.z; v[3] = a.w; v[4] = b.x; v[5] = b.y; v[6] = b.z; v[7] = b.w; }
__device__ __forceinline__ void st8(bf16* p, const float (&v)[8]) { u32x4 w; w.x = pk2(v[0], v[1]); w.y = pk2(v[2], v[3]); w.z = pk2(v[4], v[5]); w.w = pk2(v[6], v[7]); *(u32x4*)p = w; }

__device__ __forceinline__ void fconv_phase(const bf16* H, bf16* ACT, const float* cw, const float* cb) {
    const int gt = blockIdx.x * 512 + otid(), NGT = gridDim.x * 512;
    constexpr int NCG = DFF / 8, NITEMS = (MH / 8) * NCG;
    for (int it = gt; it < NITEMS; it += NGT) {
        const int cgx = it % NCG, run = it / NCG, r0 = run * 8, t0 = r0 & (SEQ - 1), j0 = cgx * 8;
        float wg[3][8], wv[3][8], bg[8], bv[8];
#pragma unroll
        for (int k = 0; k < 3; ++k) { ldf8(cw + k * DFF2 + j0, wg[k]); ldf8(cw + k * DFF2 + DFF + j0, wv[k]); }
        ldf8(cb + j0, bg); ldf8(cb + DFF + j0, bv);
        float gm[8], g0[8], gp[8], vm[8], v0[8], vp[8];
        const bf16* hp = H + (size_t)r0 * DFF2 + j0;
        if (t0 > 0) { ld8(hp - DFF2, gm); ld8(hp - DFF2 + DFF, vm); } else {
#pragma unroll
            for (int c = 0; c < 8; ++c) { gm[c] = 0.f; vm[c] = 0.f; } }
        ld8(hp, g0); ld8(hp + DFF, v0);
#pragma unroll
        for (int i = 0; i < 8; ++i) {
            if (i < 7 || t0 + 8 < SEQ) { ld8(hp + (size_t)(i + 1) * DFF2, gp); ld8(hp + (size_t)(i + 1) * DFF2 + DFF, vp); } else {
#pragma unroll
                for (int c = 0; c < 8; ++c) { gp[c] = 0.f; vp[c] = 0.f; } }
            float o[8];
#pragma unroll
            for (int c = 0; c < 8; ++c) { const float G = bg[c] + wg[0][c] * gm[c] + wg[1][c] * g0[c] + wg[2][c] * gp[c]; const float V = bv[c] + wv[0][c] * vm[c] + wv[1][c] * v0[c] + wv[2][c] * vp[c]; o[c] = siluf(G) * V; }
            st8(ACT + (size_t)(r0 + i) * DFF + j0, o);
#pragma unroll
            for (int c = 0; c < 8; ++c) { gm[c] = g0[c]; g0[c] = gp[c]; vm[c] = v0[c]; v0[c] = vp[c]; }
        }
    }
}

__device__ __forceinline__ void sconv_phase(const bf16* RAW, bf16* CONV, float* DT, const float* cw, const float* cb, const float* dtb) {
    const int gt = blockIdx.x * 512 + otid(), NGT = gridDim.x * 512;
    constexpr int NCG = CONVD / 8, NITEMS = (MH / 8) * NCG;
    for (int it = gt; it < NITEMS; it += NGT) {
        const int cgx = it % NCG, run = it / NCG, r0 = run * 8, t0 = r0 & (SEQ - 1), j0 = cgx * 8;
        float w[5][8], bb[8];
#pragma unroll
        for (int k = 0; k < 5; ++k) ldf8(cw + k * CONVD + j0, w[k]);
        ldf8(cb + j0, bb);
        float win[5][8];
        const bf16* hp = RAW + (size_t)r0 * CONVD + j0;
#pragma unroll
        for (int k = 0; k < 4; ++k) { const int dt_ = k - 2;
            if (t0 + dt_ >= 0) ld8(hp + (ptrdiff_t)dt_ * CONVD, win[k]); else {
#pragma unroll
                for (int c = 0; c < 8; ++c) win[k][c] = 0.f; } }
#pragma unroll
        for (int i = 0; i < 8; ++i) {
            if (t0 + i + 2 < SEQ) ld8(hp + (size_t)(i + 2) * CONVD, win[4]); else {
#pragma unroll
                for (int c = 0; c < 8; ++c) win[4][c] = 0.f; }
            float o[8];
#pragma unroll
            for (int c = 0; c < 8; ++c) { const float v = bb[c] + w[0][c] * win[0][c] + w[1][c] * win[1][c] + w[2][c] * win[2][c] + w[3][c] * win[3][c] + w[4][c] * win[4][c]; o[c] = siluf(v); }
            st8(CONV + (size_t)(r0 + i) * CONVD + j0, o);
#pragma unroll
            for (int k = 0; k < 4; ++k)
#pragma unroll
                for (int c = 0; c < 8; ++c) win[k][c] = win[k + 1][c];
        }
    }
    for (int i = gt; i < MH * 64; i += NGT) { const float v = DT[i] + dtb[i & 63]; DT[i] = fmaxf(v, 0.f) + __logf(1.f + __expf(-fabsf(v))); }
}

constexpr int M2_RS = 272, M2_RSX = 80;
constexpr int M2_C = 0, M2_B = 34816, M2_M = 69632, M2_XDT = 104448, M2_XDEC = 114688, M2_S0 = 124928, M2_S1 = 133632, M2_E = 142336, M2_DTV = 142848, M2_TOT = 143360;
__device__ __forceinline__ bf16x8 tr_frag(LAS3 unsigned char* base, int off0, int rs) {
    const v4i16_t lo = __builtin_amdgcn_ds_read_tr16_b64_v4i16((LAS3 v4i16_t*)(base + off0));
    const v4i16_t hi = __builtin_amdgcn_ds_read_tr16_b64_v4i16((LAS3 v4i16_t*)(base + off0 + 4 * rs));
    return (bf16x8){lo[0], lo[1], lo[2], lo[3], hi[0], hi[1], hi[2], hi[3]};
}
__device__ __forceinline__ bf16 f2bf_s(float f) { return (bf16)(pk2(f, 0.f) & 0xffffu); }
#define M2_BAR() asm volatile("s_waitcnt lgkmcnt(0)\n\ts_barrier" ::: "memory")
__device__ __forceinline__ void march_scan(LAS3 unsigned char* sb_, const float* DT, size_t rbase, int col, float A, int dir, int lane) {
    LAS3 float* sE = (LAS3 float*)sb_; LAS3 float* sDt = (LAS3 float*)(sb_ + 512); LAS3 float* sTot = (LAS3 float*)(sb_ + 1024);
    const float dt0 = DT[(rbase + 2 * lane) * 64 + col], dt1 = DT[(rbase + 2 * lane + 1) * 64 + col];
    const float a0 = dt0 * A, a1 = dt1 * A, ps = a0 + a1; float inc = ps;
#pragma unroll
    for (int d = 1; d < 64; d <<= 1) { const float t = __shfl_up(inc, d); if (lane >= d) inc += t; }
    const float tot = __shfl(inc, 63);
    float e0 = inc - a1, e1 = inc;
    if (dir) { e0 = tot - e0 + a0; e1 = tot - e1 + a1; }
    constexpr float L2E = 1.4426950408889634f;
    sE[2 * lane] = e0 * L2E; sE[2 * lane + 1] = e1 * L2E; sDt[2 * lane] = dt0; sDt[2 * lane + 1] = dt1;
    if (lane == 0) sTot[0] = tot * L2E;
}
__device__ __forceinline__ void march_phase(unsigned char* lds_g, const bf16* CONV, const float* DT, bf16* YF, bf16* YB, const float* alog) {
    LAS3 unsigned char* lds = (LAS3 unsigned char*)lds_g;
    const int tid = otid(), lane = tid & 63, wave = __builtin_amdgcn_readfirstlane(tid >> 6);
    const int h = lane >> 5, l32 = lane & 31, blk = (lane >> 4) & 1, q4 = (lane & 15) >> 2, p4 = lane & 3;
    constexpr int SCAN_STRIDE = 1040;
    for (int it = blockIdx.x; it < 256; it += gridDim.x) {
        const int xcd = it & 7, slot = it >> 3, set = xcd * 4 + (slot >> 3), mem = slot & 7;
        const int bl = set >> 4, grp = (set >> 1) & 7, dir = set & 1, head = grp * 4 + (mem >> 1), ph = mem & 1;
        const float A = -__expf(alog[dir * 32 + head]);
        bf16* Y = dir ? YB : YF;
        f32x16 Sacc;
#pragma unroll
        for (int i = 0; i < 16; ++i) Sacc[i] = 0.f;
        __syncthreads();
        for (int i = tid; i < 8704 / 16; i += 512) *(LAS3 u32x4*)(lds + M2_S0 + i * 16) = (u32x4){0u, 0u, 0u, 0u};
        u32x4 rc[4], rb[4], rx;
        {   const size_t rbase = (size_t)bl * SEQ + (size_t)(dir ? 63 : 0) * 128;
#pragma unroll
            for (int q = 0; q < 4; ++q) { const int idx = tid + 512 * q, row = idx >> 4, part = idx & 15;
                const bf16* bc = CONV + (size_t)2048 * MH + ((size_t)grp * MH + rbase + row) * 256 + part * 8;
                rb[q] = *(const u32x4*)bc; rc[q] = *(const u32x4*)(bc + 128); }
            rx = *(const u32x4*)(CONV + ((size_t)(head * 2 + ph) * MH + rbase + (tid >> 2)) * 32 + (tid & 3) * 8);
            if (wave == 4) march_scan(lds + M2_E, DT, rbase, dir * 32 + head, A, dir, lane);
        }
        for (int ci = 0; ci < 64; ++ci) {
            const int c = dir ? (63 - ci) : ci;
            const size_t rbase = (size_t)bl * SEQ + (size_t)c * 128;
            LAS3 unsigned char* scb = lds + M2_E + (ci & 1) * SCAN_STRIDE;
            LAS3 float* sE = (LAS3 float*)scb; LAS3 float* sDt = (LAS3 float*)(scb + 512);
            M2_BAR();
#pragma unroll
            for (int q = 0; q < 4; ++q) { const int idx = tid + 512 * q, row = idx >> 4, part = idx & 15;
                *(LAS3 u32x4*)(lds + M2_C + row * M2_RS + part * 16) = rc[q];
                *(LAS3 u32x4*)(lds + M2_B + row * M2_RS + part * 16) = rb[q]; }
            const float tot = *(LAS3 float*)(scb + 1024);
            {   const int row = tid >> 2, part = tid & 3; const float dtv = sDt[row], f2 = dtv * __builtin_amdgcn_exp2f(tot - sE[row]);
                float xv[8]; xv[0] = bflo(rx.x); xv[1] = bfhi(rx.x); xv[2] = bflo(rx.y); xv[3] = bfhi(rx.y); xv[4] = bflo(rx.z); xv[5] = bfhi(rx.z); xv[6] = bflo(rx.w); xv[7] = bfhi(rx.w);
                u32x4 w1, w2;
                w1.x = pk2(xv[0] * dtv, xv[1] * dtv); w1.y = pk2(xv[2] * dtv, xv[3] * dtv); w1.z = pk2(xv[4] * dtv, xv[5] * dtv); w1.w = pk2(xv[6] * dtv, xv[7] * dtv);
                w2.x = pk2(xv[0] * f2, xv[1] * f2); w2.y = pk2(xv[2] * f2, xv[3] * f2); w2.z = pk2(xv[4] * f2, xv[5] * f2); w2.w = pk2(xv[6] * f2, xv[7] * f2);
                *(LAS3 u32x4*)(lds + M2_XDT + row * M2_RSX + part * 16) = w1;
                *(LAS3 u32x4*)(lds + M2_XDEC + row * M2_RSX + part * 16) = w2; }
            M2_BAR();
            const int cn = dir ? (62 - ci) : (ci + 1); const size_t rb2 = (size_t)bl * SEQ + (size_t)cn * 128;
            if (ci + 1 < 64) {
#pragma unroll
                for (int q = 0; q < 4; ++q) { const int idx = tid + 512 * q, row = idx >> 4, part = idx & 15;
                    const bf16* bc = CONV + (size_t)2048 * MH + ((size_t)grp * MH + rb2 + row) * 256 + part * 8;
                    rb[q] = *(const u32x4*)bc; rc[q] = *(const u32x4*)(bc + 128); }
                rx = *(const u32x4*)(CONV + ((size_t)(head * 2 + ph) * MH + rb2 + (tid >> 2)) * 32 + (tid & 3) * 8);
            }
            for (int rep1 = 0; rep1 < (MPROBE == 1 ? 2 : 1); ++rep1)
            {
                const int sh4 = 4 * wave, rbF = (0x02101233 >> sh4) & 15, c0F = (0x02001020 >> sh4) & 15, ntl = (0x01111222 >> sh4) & 15;
                const int rbk = dir ? 3 - rbF : rbF, cb0 = dir ? ((ntl == 2 ? 2 : 3) - c0F) : c0F;
                const bool need0 = ntl >= 1, need1 = ntl >= 2;
                f32x16 g0, g1;
#pragma unroll
                for (int i = 0; i < 16; ++i) { g0[i] = 0.f; g1[i] = 0.f; }
                if (need0 || need1) {
#pragma unroll
                    for (int kk = 0; kk < 8; ++kk) {
                        const bf16x8 av = *(const LAS3 bf16x8*)(lds + M2_C + (32 * rbk + l32) * M2_RS + (16 * kk + 8 * h) * 2);
                        if (need0) { const bf16x8 bv = *(const LAS3 bf16x8*)(lds + M2_B + (32 * cb0 + l32) * M2_RS + (16 * kk + 8 * h) * 2); g0 = __builtin_amdgcn_mfma_f32_32x32x16_bf16(av, bv, g0, 0, 0, 0); }
                        if (need1) { const bf16x8 bv = *(const LAS3 bf16x8*)(lds + M2_B + (32 * (cb0 + 1) + l32) * M2_RS + (16 * kk + 8 * h) * 2); g1 = __builtin_amdgcn_mfma_f32_32x32x16_bf16(av, bv, g1, 0, 0, 0); }
                    }
                }
                int oz = 0; asm volatile("" : "+v"(oz));
                const int s0 = 32 * cb0 + l32 + oz, s1 = s0 + 32;
#pragma unroll
                for (int t = 0; t < 2; ++t) {
                    const bool need = t ? need1 : need0; const int sc = t ? s1 : s0; const bool diag = (cb0 + t) == rbk;
                    LAS3 unsigned char* mrow = lds + M2_M + sc * M2_RS + (32 * rbk + 4 * h) * 2;
                    if (need) {
                        const float Es = sE[sc];
#pragma unroll
                        for (int i4 = 0; i4 < 4; ++i4) {
                            float v[4];
#pragma unroll
                            for (int e = 0; e < 4; ++e) { const int i = 4 * i4 + e, l = 32 * rbk + 8 * i4 + 4 * h + e;
                                const float gg = t ? g1[i] : g0[i]; float x = gg * __builtin_amdgcn_exp2f(sE[l] - Es);
                                if (diag) { const bool ok = dir ? (sc >= l) : (sc <= l); x = ok ? x : 0.f; }
                                v[e] = x; }
                            u32x2 w; w.x = pk2(v[0], v[1]); w.y = pk2(v[2], v[3]);
                            *(LAS3 u32x2*)(mrow + 16 * i4) = w;
                        }
                    }
                }
            }
            M2_BAR();
            LAS3 unsigned char* sScur = lds + ((ci & 1) ? M2_S1 : M2_S0); LAS3 unsigned char* sSnxt = lds + ((ci & 1) ? M2_S0 : M2_S1);
            for (int rep2 = 0; rep2 < (MPROBE == 2 ? 2 : 1); ++rep2)
            if (wave < 4) {
                const int l0 = 32 * wave;
                f32x16 yd, yo;
#pragma unroll
                for (int i = 0; i < 16; ++i) { yd[i] = 0.f; yo[i] = 0.f; }
                const int klo = dir ? 2 * wave : 0, khi = dir ? 8 : 2 * (wave + 1);
#pragma unroll
                for (int kk = 0; kk < 8; ++kk) {
                    if (kk >= klo && kk < khi) {
                        const bf16x8 av = tr_frag(lds + M2_M, (16 * kk + 8 * h + q4) * M2_RS + (l0 + 16 * blk + 4 * p4) * 2, M2_RS);
                        const bf16x8 bv = tr_frag(lds + M2_XDT, (16 * kk + 8 * h + q4) * M2_RSX + (16 * blk + 4 * p4) * 2, M2_RSX);
                        yd = __builtin_amdgcn_mfma_f32_32x32x16_bf16(av, bv, yd, 0, 0, 0); }
                    const bf16x8 av2 = *(const LAS3 bf16x8*)(lds + M2_C + (l0 + l32) * M2_RS + (16 * kk + 8 * h) * 2);
                    const bf16x8 bv2 = *(const LAS3 bf16x8*)(sScur + l32 * M2_RS + (16 * kk + 8 * h) * 2);
                    yo = __builtin_amdgcn_mfma_f32_32x32x16_bf16(av2, bv2, yo, 0, 0, 0);
                }
#pragma unroll
                for (int i = 0; i < 16; ++i) { const int l = l0 + 8 * (i >> 2) + 4 * h + (i & 3);
                    const float y = yd[i] + __builtin_amdgcn_exp2f(sE[l]) * yo[i];
                    Y[(rbase + l) * DIN + head * 64 + ph * 32 + l32] = f2bf_s(y); }
            } else {
                const int n0 = 32 * (wave - 4);
                const float et = __builtin_amdgcn_exp2f(tot);
#pragma unroll
                for (int i = 0; i < 16; ++i) Sacc[i] *= et;
#pragma unroll
                for (int kk = 0; kk < 8; ++kk) {
                    const bf16x8 av = tr_frag(lds + M2_XDEC, (16 * kk + 8 * h + q4) * M2_RSX + (16 * blk + 4 * p4) * 2, M2_RSX);
                    const bf16x8 bv = tr_frag(lds + M2_B, (16 * kk + 8 * h + q4) * M2_RS + (n0 + 16 * blk + 4 * p4) * 2, M2_RS);
                    Sacc = __builtin_amdgcn_mfma_f32_32x32x16_bf16(av, bv, Sacc, 0, 0, 0);
                }
#pragma unroll
                for (int i4 = 0; i4 < 4; ++i4)
#pragma unroll
                    for (int e = 0; e < 4; ++e) { const int p = 8 * i4 + 4 * h + e;
                        *(LAS3 bf16*)(sSnxt + p * M2_RS + (n0 + l32) * 2) = f2bf_s(Sacc[4 * i4 + e]); }
                if (wave == 4 && ci + 1 < 64) march_scan(lds + M2_E + ((ci + 1) & 1) * SCAN_STRIDE, DT, rb2, dir * 32 + head, A, dir, lane);
            }
        }
        asm volatile("s_waitcnt vmcnt(0)" ::: "memory");
    }
}

__device__ __forceinline__ void comb_phase(bf16* Z, const bf16* YF, const bf16* YB, const float* gg, const bf16* CONV, const float* dsk) {
    const int tid = otid(), lane = tid & 63, wave = tid >> 6, l5 = lane & 31, hsel = lane >> 5;
    const int gw = blockIdx.x * 8 + wave, NGW = gridDim.x * 8;
    for (int ip = gw; ip < MH * 4; ip += NGW) {
        const int it = 2 * ip + hsel, g = it & 7, r = it >> 3; const int c0 = g * 256 + 8 * l5; const size_t off = (size_t)r * DIN + c0;
        const u32x4 a = __builtin_nontemporal_load((const u32x4*)(YF + off)), b = __builtin_nontemporal_load((const u32x4*)(YB + off)), z = *(const u32x4*)(Z + off);
        const u32x4 xr = *(const u32x4*)(CONV + ((size_t)(c0 >> 5) * MH + r) * 32 + (c0 & 31)); const float dh = dsk[g * 4 + (l5 >> 3)];
        const f32x4 gv0 = *(const f32x4*)(gg + c0), gv1 = *(const f32x4*)(gg + c0 + 4);
        float y[8];
        y[0] = (bflo(a.x) + bflo(b.x) + dh * bflo(xr.x)) * siluf(bflo(z.x)); y[1] = (bfhi(a.x) + bfhi(b.x) + dh * bfhi(xr.x)) * siluf(bfhi(z.x));
        y[2] = (bflo(a.y) + bflo(b.y) + dh * bflo(xr.y)) * siluf(bflo(z.y)); y[3] = (bfhi(a.y) + bfhi(b.y) + dh * bfhi(xr.y)) * siluf(bfhi(z.y));
        y[4] = (bflo(a.z) + bflo(b.z) + dh * bflo(xr.z)) * siluf(bflo(z.z)); y[5] = (bfhi(a.z) + bfhi(b.z) + dh * bfhi(xr.z)) * siluf(bfhi(z.z));
        y[6] = (bflo(a.w) + bflo(b.w) + dh * bflo(xr.w)) * siluf(bflo(z.w)); y[7] = (bfhi(a.w) + bfhi(b.w) + dh * bfhi(xr.w)) * siluf(bfhi(z.w));
        float ss = ((y[0] * y[0] + y[1] * y[1]) + (y[2] * y[2] + y[3] * y[3])) + ((y[4] * y[4] + y[5] * y[5]) + (y[6] * y[6] + y[7] * y[7]));
#pragma unroll
        for (int o = 1; o < 32; o <<= 1) ss += __shfl_xor(ss, o);
        const float rs = rsqrtf(ss * (1.0f / 256.0f) + EPSF);
        u32x4 w; w.x = pk2(y[0] * rs * gv0.x, y[1] * rs * gv0.y); w.y = pk2(y[2] * rs * gv0.z, y[3] * rs * gv0.w); w.z = pk2(y[4] * rs * gv1.x, y[5] * rs * gv1.y); w.w = pk2(y[6] * rs * gv1.z, y[7] * rs * gv1.w);
        *(u32x4*)(Z + off) = w;
    }
}

#define LAS __attribute__((address_space(3)))
#define XB_TMO      128
#define XB_XCNT(j)  (256  + 64 * (j))
#define XB_XSUB(j)  (1280 + 64 * (j))
#define XB_XGEN(j)  (2304 + 64 * (j))
#define XB_TOP      3328
#define XB_TOPGEN   3392
#define XCD_BAR_WORDS 3456
#define XB_SPIN_CAP (1u << 18)

__device__ __forceinline__ unsigned xb_ld(unsigned* p)              { return __hip_atomic_load(p, __ATOMIC_RELAXED, __HIP_MEMORY_SCOPE_AGENT); }
__device__ __forceinline__ unsigned xb_add(unsigned* p, unsigned v) { return __hip_atomic_fetch_add(p, v, __ATOMIC_RELAXED, __HIP_MEMORY_SCOPE_AGENT); }
__device__ __forceinline__ unsigned xb_xcc_id() { return (unsigned)__builtin_amdgcn_s_getreg((3 << 11) | 20) & 0xFu; }
#define XB_SPIN(cond, bar) do { unsigned _sp = 0; while (cond) { __builtin_amdgcn_s_sleep(1); \
    if ((++_sp & 255u) == 0u) { if (xb_ld(&(bar)[XB_TMO])) break; if (_sp > XB_SPIN_CAP) { atomicAdd(&(bar)[XB_TMO], 1u); break; } } } } while (0)

struct XcdBarrier {
    unsigned* bar; unsigned x;
    volatile LAS unsigned* st;
};

__device__ __forceinline__ XcdBarrier xcd_barrier_post(unsigned* bar, volatile LAS unsigned* st) {
    XcdBarrier b; b.bar = bar; b.x = xb_xcc_id(); b.st = st;
    if (threadIdx.x == 0) (void)xb_add(&bar[XB_XCNT(b.x)], 1u);
    return b;
}
__device__ __forceinline__ void xcd_barrier_complete(unsigned* bar, unsigned x, unsigned& nloc, unsigned& nx) {
    const unsigned G = gridDim.x * gridDim.y * gridDim.z;
    unsigned sum, cnt, mine, sp = 0u;
    for (;;) {
        sum = 0u; cnt = 0u; mine = 0u;
#pragma unroll
        for (unsigned j = 0; j < 16; ++j) { const unsigned c = xb_ld(&bar[XB_XCNT(j)]); sum += c; cnt += (c > 0u) ? 1u : 0u; mine = (j == x) ? c : mine; }
        if (sum == G) break;
        __builtin_amdgcn_s_sleep(1);
        if ((++sp & 255u) == 0u) { if (xb_ld(&bar[XB_TMO])) break; if (sp > XB_SPIN_CAP) { atomicAdd(&bar[XB_TMO], 1u); break; } }
    }
    nloc = mine > 0u ? mine : 1u; nx = cnt > 0u ? cnt : 1u;
}

__device__ __forceinline__ void xcd_barrier(const XcdBarrier& b) {
    asm volatile("s_waitcnt vmcnt(0)" ::: "memory");
    __syncthreads();
    if (threadIdx.x == 0) {
        unsigned* bar = b.bar;
        __builtin_amdgcn_s_waitcnt(0);
        unsigned nloc = b.st[0], nx = b.st[1];
        if (nloc == 0u) { xcd_barrier_complete(bar, b.x, nloc, nx); b.st[0] = nloc; b.st[1] = nx; }
        const unsigned old = xb_add(&bar[XB_XSUB(b.x)], 1u);
        const unsigned gen = old / nloc;
        if (old + 1u == (gen + 1u) * nloc) {
            __builtin_amdgcn_fence(__ATOMIC_RELEASE, "agent");
            asm volatile("s_waitcnt vmcnt(0)" ::: "memory");
            const unsigned og = xb_add(&bar[XB_TOP], 1u);
            const unsigned tg = og / nx;
            if (og + 1u == (tg + 1u) * nx) xb_add(&bar[XB_TOPGEN], 1u);
            else XB_SPIN(xb_ld(&bar[XB_TOPGEN]) == tg, bar);
            __builtin_amdgcn_fence(__ATOMIC_ACQUIRE, "agent");
            xb_add(&bar[XB_XGEN(b.x)], 1u);
            asm volatile("s_waitcnt vmcnt(0)" ::: "memory");
        } else {
            XB_SPIN(xb_ld(&bar[XB_XGEN(b.x)]) == gen, bar);
            __builtin_amdgcn_fence(__ATOMIC_ACQUIRE, "agent");
            asm volatile("s_waitcnt vmcnt(0)" ::: "memory");
        }
    }
    __syncthreads();
}

constexpr int LDS_BYTES = 147456;
__global__ void __launch_bounds__(512, 2) mega_fwd(Args a) {
    __shared__ __attribute__((aligned(16))) unsigned char lds[LDS_BYTES];
    if (a.nsteps < 0) cg::this_grid().sync();
    unsigned char* ws = a.ws;
    volatile LAS unsigned* bst = (volatile LAS unsigned*)((LAS unsigned char*)lds + 147456 - 16);
    if (threadIdx.x < 2) bst[threadIdx.x] = 0u;
    __syncthreads();
    const XcdBarrier gbar = xcd_barrier_post((unsigned*)(ws + WS_BAR), bst);
    phase0(a, lds);
    xcd_barrier(gbar);
    if (PROBE == 8) { phase0(a, lds); xcd_barrier(gbar); }
    float* SS = (float*)(ws + WS_SS);
    bf16* XB = (bf16*)(ws + WS_XB);
    const float* rope = (const float*)(ws + WS_ROPE);
    for (int s = 0; s < a.nsteps; ++s) {
        const Step st = a.steps[s];
        const int L = st.layer, j = L >> 1, hb = st.hb;
        const size_t rowoff = (size_t)hb * MH;
        if (st.kind == K_GEMM) {
            pg8::Gemm g; EP e;
            e.mode = 0; e.ss_in = nullptr; e.o0 = nullptr; e.ld0 = 0; e.c0 = 0; e.o1 = nullptr; e.ld1 = 0; e.c1 = 0; e.o2 = nullptr; e.ld2 = 0; e.c2 = 0; e.pad = 0;
            e.base = nullptr; e.out = nullptr; e.xb = nullptr; e.ss_out = nullptr; e.cw = nullptr; e.cb = nullptr;
            const int sub = st.sub;
            if (sub == 0) {
                g.A = XB; g.Bt = (const bf16*)(ws + WS_W + j * W_ATT_STRIDE); g.M = MTOK; g.N = QKVD; g.K = DM;
                e.ss_in = SS; e.o0 = (bf16*)(ws + R_QKV); e.ld0 = QKVD; e.c0 = QKVD; e.c1 = QKVD; e.c2 = QKVD;
            } else if (sub == 6) {
                g.A = XB; g.Bt = (const bf16*)(ws + WS_W + j * W_ATT_STRIDE); g.M = MTOK; g.N = QKVD; g.K = DM;
                e.mode = 4; e.o0 = (bf16*)(ws + WS_R + 160 * MiB); e.ld0 = QKVD;
            } else if (sub == 1) {
                g.A = (const bf16*)(ws + R_OB); g.Bt = (const bf16*)(ws + WS_W + j * W_ATT_STRIDE + W_ATT_WO); g.M = MTOK; g.N = DM; g.K = DM;
                e.mode = 1; e.out = nullptr; e.xb = XB; e.ss_out = SS;
            } else if (sub == 2) {
                g.A = XB + rowoff * DM; g.Bt = (const bf16*)(ws + WS_W + W_SSD0 + j * W_SSD_STRIDE); g.M = 68 * 256; g.N = SSDINP; g.K = DM;
                e.mode = 3; e.ss_in = SS + rowoff * 4; e.o0 = (bf16*)(ws + R_Z); e.o1 = (bf16*)(ws + R_CONV); e.o2 = (float*)(ws + R_DT);
                e.cw = (const float*)(ws + WS_SWP) + (size_t)j * (CONVD / 4) * 24; e.cb = a.in[11] + j * 64;
            } else if (sub == 3) {
                g.A = (const bf16*)(ws + R_Z); g.Bt = (const bf16*)(ws + WS_W + W_SSD0 + j * W_SSD_STRIDE + W_SSD_WOUT); g.M = MH; g.N = DM; g.K = DIN;
                e.mode = 1; e.out = nullptr; e.xb = XB + rowoff * DM; e.ss_out = SS + rowoff * 4;
            } else if (sub == 4) {
                g.A = XB; g.Bt = (const bf16*)(ws + WS_W + W_FFN0 + L * W_FFN_STRIDE); g.M = 132 * 256; g.N = DFF2; g.K = DM;
                e.mode = 2; e.ss_in = SS; e.o0 = (bf16*)(ws + R_ACT); e.cw = (const float*)(ws + WS_CWP) + (size_t)L * (DFF / 4) * 32; e.cb = nullptr;
            } else {
                g.A = (const bf16*)(ws + R_ACT); g.Bt = (const bf16*)(ws + WS_W + W_FFN0 + L * W_FFN_STRIDE + W_FFN_DOWN); g.M = MTOK; g.N = DM; g.K = DFF;
                e.mode = 1; e.out = (L == 3) ? a.out : nullptr; e.xb = XB; e.ss_out = SS;
            }
            PG8_LAS EP* epl = (PG8_LAS EP*)((PG8_LAS unsigned char*)lds + 131072);
            if (otid() == 0) { epl->mode = e.mode; epl->ld0 = e.ld0; epl->c0 = e.c0; epl->ld1 = e.ld1; epl->c1 = e.c1; epl->ld2 = e.ld2; epl->c2 = e.c2; epl->pad = 0;
                epl->ss_in = e.ss_in; epl->o0 = e.o0; epl->o1 = e.o1; epl->o2 = e.o2; epl->base = e.base; epl->out = e.out; epl->xb = e.xb; epl->ss_out = e.ss_out; epl->cw = e.cw; epl->cb = e.cb; }
            __syncthreads();
            EpiG E; E.ep = epl;
            pg8::StaticOrder S; S.init(g.M, g.N, (int)gridDim.x, (int)blockIdx.x);
            g.amode = (sub == 4) ? 1 : (sub == 2) ? 2 : 0;
            pg8::gemm_phase<EpiG, pg8::StaticOrder, true, true>((PG8_LAS unsigned char*)lds, g, S, E);
        } else if (st.kind == K_ATTN) {
            attn_phase(lds, (const bf16*)(ws + R_QKV), (bf16*)(ws + R_OB), a.in[3] + j * 64, a.in[4] + j * 64, a.in[5] + j * 16, rope);
        } else if (st.kind == K_FCONV) {
            ;
        } else if (st.kind == K_SCONV) {
            sconv_phase((const bf16*)(ws + R_RAW), (bf16*)(ws + R_CONV), (float*)(ws + R_DT), a.in[9] + (size_t)j * 5 * CONVD, a.in[10] + (size_t)j * CONVD, a.in[11] + j * 64);
        } else if (st.kind == K_MARCH) {
            march_phase(lds, (const bf16*)(ws + R_CONV), (const float*)(ws + R_DT), (bf16*)(ws + R_YF), (bf16*)(ws + R_YB), a.in[12] + j * 64);
        } else if (st.kind == K_COMB) {
            comb_phase((bf16*)(ws + R_Z), (const bf16*)(ws + R_YF), (const bf16*)(ws + R_YB), a.in[14] + (size_t)j * DIN, (const bf16*)(ws + R_CONV), a.in[13] + j * 32);
        }
        xcd_barrier(gbar);
    }
}

extern "C" void kernel_launch(void* const* d_in, const int* in_sizes, int n_in, void* d_out, int out_size, void* d_ws, size_t ws_size, hipStream_t stream) {
    static int grid = 0;
    if (grid == 0) {
        if (n_in != 21 || out_size != MTOK * DM || ws_size < WS_END) { fprintf(stderr, "kernel_launch: unexpected shapes (n_in %d out %d ws %zu)\n", n_in, out_size, ws_size); grid = -1; return; }
        int dev = 0, cus = 0, per_cu = 0;
        hipGetDevice(&dev); hipDeviceGetAttribute(&cus, hipDeviceAttributeMultiprocessorCount, dev);
        hipOccupancyMaxActiveBlocksPerMultiprocessor(&per_cu, (const void*)mega_fwd, 512, 0);
        if (per_cu < 1) per_cu = 1;
        grid = cus;
    }
    if (grid < 0) return;
    Args a{};
    for (int i = 0; i < 21; ++i) a.in[i] = (const float*)d_in[i];
    a.out = (float*)d_out; a.ws = (unsigned char*)d_ws;
    int n = 0;
    auto add = [&](int kind, int layer, int sub, int hb) { a.steps[n].kind = kind; a.steps[n].layer = layer; a.steps[n].sub = sub; a.steps[n].hb = hb; ++n; };
    for (int L = 0; L < 4; ++L) {
        if ((L & 1) == 0) { add(K_GEMM, L, 0, 0); if (PROBE == 5) add(K_GEMM, L, 0, 0); if (PROBE == 7) add(K_GEMM, L, 6, 0); add(K_ATTN, L, 0, 0); if (PROBE == 3) add(K_ATTN, L, 0, 0); add(K_GEMM, L, 1, 0); }
        else for (int hb = 0; hb < 2; ++hb) { add(K_GEMM, L, 2, hb); if (PROBE == 4) add(K_GEMM, L, 2, hb); add(K_MARCH, L, 0, hb); if (PROBE == 2) add(K_MARCH, L, 0, hb); add(K_COMB, L, 0, hb); add(K_GEMM, L, 3, hb); }
        add(K_GEMM, L, 4, 0); if (PROBE == 1) add(K_GEMM, L, 4, 0); add(K_GEMM, L, 5, 0);
        if (PROBE == 6) for (int r = 0; r < 8; ++r) add(99, L, 0, 0);
    }
    a.nsteps = n;
    if (hipMemsetAsync(d_ws, 0, 16384, stream) != hipSuccess) { fprintf(stderr, "memset of the barrier words failed\n"); return; }
    void* args[] = {&a};
    hipError_t e = hipLaunchCooperativeKernel((const void*)mega_fwd, dim3(grid), dim3(512), args, 0, stream);
    if (e != hipSuccess) fprintf(stderr, "cooperative launch failed: %s (grid %d)\n", hipGetErrorString(e), grid);
}
```
